# Optimizing an MI355X kernel written in HIP

```python
import jax, jax.numpy as jnp
from jax import lax
import numpy as np

D_MODEL = 1024
BATCH = 4
SEQ = 4096
DEPTH = 1

ATTN_HEADS = 16
ATTN_KV_HEADS = 4
ATTN_HEAD_DIM = 64
ATTN_GROUPS = ATTN_HEADS // ATTN_KV_HEADS
ATTN_WIDTH = ATTN_HEADS * ATTN_HEAD_DIM
ATTN_KV_WIDTH = ATTN_KV_HEADS * ATTN_HEAD_DIM
WINDOW = 128
ATTN_BLOCK = 128

MLSTM_HEADS = 8
MLSTM_QK_DIM = 64
MLSTM_V_DIM = 128
MLSTM_QK_WIDTH = MLSTM_HEADS * MLSTM_QK_DIM
MLSTM_V_WIDTH = MLSTM_HEADS * MLSTM_V_DIM
MLSTM_CHUNK = 64
CONV_WIDTH = 4
FORGET_BIAS_LO = 3.0
FORGET_BIAS_HI = 6.0
M_INIT = -1e30

RMS_EPS = 1e-6

SPLIT_SIZES = (ATTN_WIDTH, ATTN_KV_WIDTH, ATTN_KV_WIDTH, ATTN_WIDTH,
               MLSTM_QK_WIDTH, MLSTM_QK_WIDTH, MLSTM_V_WIDTH, MLSTM_HEADS, MLSTM_HEADS,
               MLSTM_V_WIDTH, MLSTM_V_WIDTH, D_MODEL, D_MODEL)
SPLIT_IDX = tuple(sum(SPLIT_SIZES[:i + 1]) for i in range(len(SPLIT_SIZES) - 1))
PROJ_WIDTH = sum(SPLIT_SIZES)
F_GATE_OFFSET = sum(SPLIT_SIZES[:8])

kernel_name = 'hybrid_swa_sink_mlstm_gated_merge'


def rms_norm(x, w):
    xf = x.astype(jnp.float32)
    y = xf * lax.rsqrt(jnp.mean(xf * xf, axis=-1, keepdims=True) + RMS_EPS)
    return (y * w.astype(jnp.float32)).astype(x.dtype)


def head_rms_norm(h, w):
    y = h * lax.rsqrt(jnp.mean(h * h, axis=-1, keepdims=True) + RMS_EPS)
    return y * w.astype(jnp.float32).reshape(MLSTM_HEADS, MLSTM_V_DIM)


def sliding_window_sink_attention(q, k, v, sinks):
    B, T = q.shape[0], q.shape[1]
    nb = T // ATTN_BLOCK
    qb = q.reshape(B, nb, ATTN_BLOCK, ATTN_KV_HEADS, ATTN_GROUPS, ATTN_HEAD_DIM)
    kb = k.reshape(B, nb, ATTN_BLOCK, ATTN_KV_HEADS, ATTN_HEAD_DIM)
    vb = v.reshape(B, nb, ATTN_BLOCK, ATTN_KV_HEADS, ATTN_HEAD_DIM)

    def with_prev(t):
        prev = jnp.concatenate([jnp.zeros_like(t[:, :1]), t[:, :-1]], axis=1)
        return jnp.concatenate([prev, t], axis=2)

    kw, vw = with_prev(kb), with_prev(vb)
    scores = jnp.einsum('bnqkgd,bnskd->bnkgqs', qb, kw).astype(jnp.float32) * (ATTN_HEAD_DIM ** -0.5)
    blk = jnp.arange(nb)[:, None] * ATTN_BLOCK
    q_pos = blk + jnp.arange(ATTN_BLOCK)[None, :]
    k_pos = blk - ATTN_BLOCK + jnp.arange(2 * ATTN_BLOCK)[None, :]
    rel = q_pos[:, :, None] - k_pos[:, None, :]
    allowed = (rel >= 0) & (rel < WINDOW) & (k_pos[:, None, :] >= 0)
    scores = jnp.where(allowed[None, :, None, None], scores, -jnp.inf)
    sink = sinks.astype(jnp.float32).reshape(ATTN_KV_HEADS, ATTN_GROUPS)[None, None, :, :, None, None]
    sink = jnp.broadcast_to(sink, scores.shape[:-1] + (1,))
    probs = jax.nn.softmax(jnp.concatenate([scores, sink], axis=-1), axis=-1)[..., :-1]
    out = jnp.einsum('bnkgqs,bnskd->bnqkgd', probs.astype(v.dtype), vw)
    return out.reshape(B, T, ATTN_WIDTH)


def causal_depthwise_conv(u, w, b):
    out = lax.conv_general_dilated(u, w[:, None, :], window_strides=(1,),
                                   padding=[(CONV_WIDTH - 1, 0)],
                                   dimension_numbers=('NWC', 'WIO', 'NWC'),
                                   feature_group_count=u.shape[-1])
    return out + b


def mlstm_chunkwise(q, k, v, i_pre, f_pre):
    B, T, H, dk = q.shape
    dv = v.shape[-1]
    nc = T // MLSTM_CHUNK

    def chunked(t):
        return jnp.moveaxis(t.reshape((B, nc, MLSTM_CHUNK) + t.shape[2:]), 3, 1)

    q = chunked(q) * (dk ** -0.5)
    k = chunked(k)
    v = chunked(v)
    ig = chunked(i_pre)
    logf = jax.nn.log_sigmoid(chunked(f_pre))
    b = jnp.cumsum(logf, axis=-1)
    causal = jnp.tril(jnp.ones((MLSTM_CHUNK, MLSTM_CHUNK), dtype=bool))
    log_d = jnp.where(causal, b[..., :, None] - b[..., None, :] + ig[..., None, :], -jnp.inf)

    g = b[..., -1]
    a = g[..., None] - b + ig
    m_loc = jnp.max(a, axis=-1)
    wts = jnp.exp(a - m_loc[..., None])
    c_loc = jnp.einsum('bhcl,bhclv,bhclk->bhcvk', wts, v, k)
    n_loc = jnp.einsum('bhcl,bhclk->bhck', wts, k)

    def step(carry, inp):
        c, n, m = carry
        g_c, m_l, c_l, n_l = inp
        m_new = jnp.maximum(g_c + m, m_l)
        s_prev = jnp.exp(g_c + m - m_new)
        s_loc = jnp.exp(m_l - m_new)
        c_new = s_prev[..., None, None] * c + s_loc[..., None, None] * c_l
        n_new = s_prev[..., None] * n + s_loc[..., None] * n_l
        return (c_new, n_new, m_new), (c, n, m)

    init = (jnp.zeros((B, H, dv, dk), q.dtype), jnp.zeros((B, H, dk), q.dtype),
            jnp.full((B, H), M_INIT, q.dtype))
    xs = (jnp.moveaxis(g, 2, 0), jnp.moveaxis(m_loc, 2, 0),
          jnp.moveaxis(c_loc, 2, 0), jnp.moveaxis(n_loc, 2, 0))
    _, (c_prev, n_prev, m_prev) = lax.scan(step, init, xs)
    c_prev = jnp.moveaxis(c_prev, 0, 2)
    n_prev = jnp.moveaxis(n_prev, 0, 2)
    m_prev = jnp.moveaxis(m_prev, 0, 2)

    m_inter = b + m_prev[..., None]
    m_row = jnp.maximum(m_inter, jnp.max(log_d, axis=-1))
    s = jnp.einsum('bhclk,bhcsk->bhcls', q, k) * jnp.exp(log_d - m_row[..., None])
    inter = jnp.exp(m_inter - m_row)
    num = jnp.einsum('bhcls,bhcsv->bhclv', s, v) + inter[..., None] * jnp.einsum('bhcvk,bhclk->bhclv', c_prev, q)
    den = jnp.sum(s, axis=-1) + inter * jnp.einsum('bhck,bhclk->bhcl', n_prev, q)
    h = num / jnp.maximum(jnp.abs(den), jnp.exp(-m_row))[..., None]
    return jnp.moveaxis(h, 1, 3).reshape(B, T, H, dv)


def hybrid_layer(x, norm_w, w_in, b_in, attn_sinks, conv_w, conv_b, mlstm_norm_w,
                 w_branch_attn, w_branch_mlstm, w_out):
    B, T, _ = x.shape
    f32 = jnp.float32
    h = rms_norm(x, norm_w)
    proj = jnp.einsum('btd,de->bte', h, w_in) + b_in
    (a_q, a_k, a_v, a_z, m_q, m_k, m_v, m_i, m_f, m_o, m_z,
     g_attn, g_mlstm) = jnp.split(proj, SPLIT_IDX, axis=-1)

    attn = sliding_window_sink_attention(a_q.reshape(B, T, ATTN_HEADS, ATTN_HEAD_DIM),
                                         a_k.reshape(B, T, ATTN_KV_HEADS, ATTN_HEAD_DIM),
                                         a_v.reshape(B, T, ATTN_KV_HEADS, ATTN_HEAD_DIM),
                                         attn_sinks)
    branch_a = jnp.einsum('bte,ed->btd', attn * jax.nn.silu(a_z), w_branch_attn)

    qk = jax.nn.silu(causal_depthwise_conv(jnp.concatenate([m_q, m_k], axis=-1), conv_w, conv_b))
    mq, mk = jnp.split(qk, 2, axis=-1)
    h_tilde = mlstm_chunkwise(mq.reshape(B, T, MLSTM_HEADS, MLSTM_QK_DIM).astype(f32),
                              mk.reshape(B, T, MLSTM_HEADS, MLSTM_QK_DIM).astype(f32),
                              m_v.reshape(B, T, MLSTM_HEADS, MLSTM_V_DIM).astype(f32),
                              m_i.astype(f32), m_f.astype(f32))
    h_m = head_rms_norm(h_tilde, mlstm_norm_w).reshape(B, T, MLSTM_V_WIDTH).astype(x.dtype)
    h_m = jax.nn.sigmoid(m_o) * h_m * jax.nn.silu(m_z)
    branch_m = jnp.einsum('bte,ed->btd', h_m, w_branch_mlstm)

    merged = jax.nn.sigmoid(g_attn) * branch_a + jax.nn.sigmoid(g_mlstm) * branch_m
    return x + jnp.einsum('btd,de->bte', merged, w_out)


def setup_inputs(seed: int = 0) -> dict:
    key = jax.random.key(seed)
    ks = jax.random.split(key, 12)
    nrm = jax.random.normal
    x = nrm(ks[0], (BATCH, SEQ, D_MODEL), jnp.float32)
    norm_w = 1.0 + 0.02 * nrm(ks[1], (DEPTH, D_MODEL), jnp.float32)
    w_in = nrm(ks[2], (DEPTH, D_MODEL, PROJ_WIDTH), jnp.float32) * (D_MODEL ** -0.5)
    b_in = 0.01 * nrm(ks[3], (DEPTH, PROJ_WIDTH), jnp.float32)
    b_in = b_in.at[:, F_GATE_OFFSET:F_GATE_OFFSET + MLSTM_HEADS].add(
        jnp.linspace(FORGET_BIAS_LO, FORGET_BIAS_HI, MLSTM_HEADS, dtype=jnp.float32))
    attn_sinks = 0.5 * nrm(ks[4], (DEPTH, ATTN_HEADS), jnp.float32)
    conv_w = nrm(ks[5], (DEPTH, CONV_WIDTH, 2 * MLSTM_QK_WIDTH), jnp.float32) * (CONV_WIDTH ** -0.5)
    conv_b = 0.01 * nrm(ks[6], (DEPTH, 2 * MLSTM_QK_WIDTH), jnp.float32)
    mlstm_norm_w = 1.0 + 0.02 * nrm(ks[7], (DEPTH, MLSTM_V_WIDTH), jnp.float32)
    w_branch_attn = nrm(ks[8], (DEPTH, ATTN_WIDTH, D_MODEL), jnp.float32) * (ATTN_WIDTH ** -0.5)
    w_branch_mlstm = nrm(ks[9], (DEPTH, MLSTM_V_WIDTH, D_MODEL), jnp.float32) * (MLSTM_V_WIDTH ** -0.5)
    w_out = nrm(ks[10], (DEPTH, D_MODEL, D_MODEL), jnp.float32) * (D_MODEL ** -0.5)
    final_norm_w = 1.0 + 0.02 * nrm(ks[11], (D_MODEL,), jnp.float32)
    return {'x': x, 'norm_w': norm_w, 'w_in': w_in, 'b_in': b_in, 'attn_sinks': attn_sinks,
            'conv_w': conv_w, 'conv_b': conv_b, 'mlstm_norm_w': mlstm_norm_w,
            'w_branch_attn': w_branch_attn, 'w_branch_mlstm': w_branch_mlstm,
            'w_out': w_out, 'final_norm_w': final_norm_w}


def reference(x, norm_w, w_in, b_in, attn_sinks, conv_w, conv_b, mlstm_norm_w,
              w_branch_attn, w_branch_mlstm, w_out, final_norm_w):
    for layer in range(DEPTH):
        x = hybrid_layer(x, norm_w[layer], w_in[layer], b_in[layer], attn_sinks[layer],
                         conv_w[layer], conv_b[layer], mlstm_norm_w[layer],
                         w_branch_attn[layer], w_branch_mlstm[layer], w_out[layer])
    return rms_norm(x, final_norm_w)
```

```cpp
#include <hip/hip_runtime.h>
#include <hip/hip_cooperative_groups.h>
#include <cstdio>
#include <cmath>
namespace pg8 {
#define PG8_LAS __attribute__((address_space(3)))
typedef unsigned short bf16_t;
typedef short bf16x8 __attribute__((ext_vector_type(8)));
typedef float f32x4 __attribute__((ext_vector_type(4)));
typedef unsigned u32x4 __attribute__((ext_vector_type(4)));
constexpr int BM = 256, BK = 64, HALF = 128, HTB = HALF * BK * 2  , STAGE_BYTES = 8 * HTB, NXCD = 8, WGM = 8;

__host__ __device__ __forceinline__ int lds_byte(int r, int c) { const int st = (r >> 4) * 2 + (c >> 5), rr = r & 15, cc = c & 31, ob = rr * 64 + cc * 2; return st * 1024 + (ob ^ (((ob >> 9) & 1) << 5)); }
__host__ __device__ __forceinline__ void stage_rc(int b, int& R, int& C) { const int st = b / 1024, sb = b % 1024, swz = sb ^ (((sb >> 9) & 1) << 5); R = (st >> 1) * 16 + swz / 64; C = (st & 1) * 32 + (swz % 64) / 2; }
__host__ __device__ __forceinline__ int perm32(int rho) { const int n = rho >> 4, i = rho & 15; return 8 * (i >> 2) + 4 * n + (i & 3); }

struct Unit { int pm, pn; };
struct Gemm { const bf16_t* A; const bf16_t* Bt; int M, N, K; };

struct StaticOrder {
    int nM, nN, nwg, G, c;
    __host__ __device__ void init(int M, int N, int G_, int c_) { nM = M / BM; nN = N / BM; nwg = nM * nN; G = G_; c = c_; }
    __host__ __device__ bool next(int i, Unit& u) const {
        const long L = (long)i * G + c; if (L >= nwg) return false;
        int wgid = (int)L; { const int q = nwg / NXCD, r = nwg % NXCD, xcd = wgid % NXCD, off = wgid / NXCD; wgid = (xcd < r ? xcd * (q + 1) : r * (q + 1) + (xcd - r) * q) + off; }
        const int nig = WGM * nN, gid = wgid / nig, fm = gid * WGM, gsz = (nM - fm) < WGM ? (nM - fm) : WGM;
        u.pm = fm + ((wgid % nig) % gsz); u.pn = (wgid % nig) / gsz; return true;
    }
    __device__ __forceinline__ void a_ready(const Unit&) const {}
    __device__ __forceinline__ void done(const Unit&) const {}
};
__device__ __forceinline__ unsigned cvt_pk_bf16(float lo, float hi) { unsigned r; asm volatile("v_cvt_pk_bf16_f32 %0, %1, %2" : "=v"(r) : "v"(lo), "v"(hi)); return r; }
template <class Epi, class Sched, bool STAMP = false>
__device__ __forceinline__ void gemm_phase(PG8_LAS unsigned char* lds, const Gemm g, const Sched& S, const Epi& E, unsigned long long* stamps) {
    const int tid = threadIdx.x, wid = __builtin_amdgcn_readfirstlane(tid >> 6), lane = tid & 63, wr = wid >> 2, wc = wid & 3, fr = lane & 15, fq = lane >> 4;
    const int K = g.K, nt = K / BK;
    int ts_lo = 0, ts_hi = 0, nts = 0; const unsigned long long rt_entry = STAMP ? (unsigned long long)wall_clock64() : 0ull;
#define PG8_STAMP() do { if (STAMP && wid == 0 && nts < 64) { const unsigned long long _c = (unsigned long long)clock64(); \
        ts_lo = (lane == nts) ? (int)(unsigned)_c : ts_lo; ts_hi = (lane == nts) ? (int)(unsigned)(_c >> 32) : ts_hi; ++nts; } } while (0)
    PG8_STAMP();
    unsigned voffA[2], voffB[2];
#pragma unroll
    for (int i = 0; i < 2; ++i) { int R, C; stage_rc(tid * 16 + i * 8192, R, C); const int Rb = Epi::PERM ? ((R & ~31) + perm32(R & 31)) : R;
        voffA[i] = (unsigned)(R * K + C) * 2u; voffB[i] = (unsigned)(Rb * K + C) * 2u; }
    const size_t kstep = (size_t)(BK * 2);
    const size_t hstep = (size_t)HALF * K * 2;
    const size_t tstep = 2 * hstep;
    const unsigned ldsw = (unsigned)wid * 1024u;
    const int aoff = lds_byte(wr * 64 + fr, fq * 8), boff = lds_byte(wc * 32 + fr, fq * 8);
#define PG8_SA(b, h) (((b) * 2 + (h)) * HTB)
#define PG8_SB(b, h) ((4 + (b) * 2 + (h)) * HTB)
#define PG8_STAGE(bufoff, gbase, voff) do { _Pragma("unroll") for (int _i = 0; _i < 2; ++_i) \
        __builtin_amdgcn_global_load_lds((const unsigned*)((const char*)(gbase) + (voff)[_i]), (PG8_LAS unsigned*)(lds + (bufoff) + ldsw + _i * 8192), 16, 0, 0); } while (0)
#define PG8_LDA(dst, b, h) do { _Pragma("unroll") for (int m = 0; m < 4; ++m) _Pragma("unroll") for (int k = 0; k < 2; ++k) dst[m][k] = *(const PG8_LAS bf16x8*)(lds + PG8_SA(b, h) + aoff + m * 2048 + k * 1024); } while (0)
#define PG8_LDB(dst, b, h) do { _Pragma("unroll") for (int n = 0; n < 2; ++n) _Pragma("unroll") for (int k = 0; k < 2; ++k) dst[n][k] = *(const PG8_LAS bf16x8*)(lds + PG8_SB(b, h) + boff + n * 2048 + k * 1024); } while (0)
#define PG8_MMA(ai, bj, At, Bt) do { __builtin_amdgcn_s_setprio(1); _Pragma("unroll") for (int m = 0; m < 4; ++m) _Pragma("unroll") for (int n = 0; n < 2; ++n) _Pragma("unroll") for (int k = 0; k < 2; ++k) \
        acc[ai][bj][m][n] = __builtin_amdgcn_mfma_f32_16x16x32_bf16(Bt[n][k], At[m][k], acc[ai][bj][m][n], 0, 0, 0); __builtin_amdgcn_s_setprio(0); } while (0)
#define PG8_WAIT_V(n) asm volatile("s_waitcnt vmcnt(" #n ")" ::: "memory")
#define PG8_WAIT_L(n) asm volatile("s_waitcnt lgkmcnt(" #n ")" ::: "memory")
#define PG8_BAR __builtin_amdgcn_s_barrier()
#define PG8_SCHED __builtin_amdgcn_sched_barrier(0)
    Unit cur, nxt; int ui = 0;
    if (!S.next(0, cur)) return;
    f32x4 acc[2][2][4][2];
#pragma unroll
    for (int a = 0; a < 2; ++a)
#pragma unroll
        for (int b = 0; b < 2; ++b)
#pragma unroll
            for (int m = 0; m < 4; ++m)
#pragma unroll
                for (int n = 0; n < 2; ++n) acc[a][b][m][n] = (f32x4){0.f, 0.f, 0.f, 0.f};
    bf16x8 At[4][2], B0[2][2], B1[2][2];
    const char* cA = (const char*)g.A + (size_t)cur.pm * tstep; const char* cB = (const char*)g.Bt + (size_t)cur.pn * tstep;
    S.a_ready(cur);
    PG8_STAGE(PG8_SB(0, 0), cB, voffB); PG8_STAGE(PG8_SA(0, 0), cA, voffA); PG8_STAGE(PG8_SB(0, 1), cB + hstep, voffB); PG8_STAGE(PG8_SA(0, 1), cA + hstep, voffA);
    if (wr == 1) PG8_BAR;
    PG8_WAIT_V(4); PG8_BAR;
    PG8_STAGE(PG8_SB(1, 0), cB + kstep, voffB); PG8_STAGE(PG8_SA(1, 0), cA + kstep, voffA); PG8_STAGE(PG8_SB(1, 1), cB + hstep + kstep, voffB);
    PG8_WAIT_V(6); PG8_BAR;
    PG8_STAMP();
    for (;;) {
        const bool has_next = S.next(ui + 1, nxt);
        const char* nA = has_next ? (const char*)g.A + (size_t)nxt.pm * tstep : cA; const char* nB = has_next ? (const char*)g.Bt + (size_t)nxt.pn * tstep : cB;
        for (int t = 0; t < nt; t += 2) {
            const bool last = (t == nt - 2);
            const char* a1 = cA + (size_t)(t + 1) * kstep;
            const char* a2 = last ? nA : cA + (size_t)(t + 2) * kstep; const char* b2 = last ? nB : cB + (size_t)(t + 2) * kstep;
            const char* a3 = a2 + kstep; const char* b3 = b2 + kstep;
            if (last && has_next) S.a_ready(nxt);
            PG8_LDB(B0, 0, 0); PG8_SCHED; PG8_LDA(At, 0, 0); PG8_STAGE(PG8_SA(1, 1), a1 + hstep, voffA);
            PG8_WAIT_L(8); PG8_BAR; PG8_WAIT_L(0); PG8_MMA(0, 0, At, B0); PG8_BAR; PG8_SCHED;
            PG8_LDB(B1, 0, 1); PG8_STAGE(PG8_SB(0, 0), b2, voffB);
            PG8_BAR; PG8_WAIT_L(0); PG8_MMA(0, 1, At, B1); PG8_BAR;
            PG8_LDA(At, 0, 1); PG8_STAGE(PG8_SA(0, 0), a2, voffA);
            PG8_BAR; PG8_WAIT_L(0); PG8_MMA(1, 0, At, B0); PG8_BAR; PG8_SCHED;
            PG8_STAGE(PG8_SB(0, 1), b2 + hstep, voffB);
            PG8_WAIT_V(6); PG8_BAR; PG8_MMA(1, 1, At, B1); PG8_BAR;
            PG8_LDB(B0, 1, 0); PG8_SCHED; PG8_LDA(At, 1, 0); PG8_STAGE(PG8_SA(0, 1), a2 + hstep, voffA);
            PG8_WAIT_L(8); PG8_BAR; PG8_WAIT_L(0); PG8_MMA(0, 0, At, B0); PG8_BAR; PG8_SCHED;
            PG8_LDB(B1, 1, 1); PG8_STAGE(PG8_SB(1, 0), b3, voffB);
            PG8_BAR; PG8_WAIT_L(0); PG8_MMA(0, 1, At, B1); PG8_BAR;
            PG8_LDA(At, 1, 1); PG8_STAGE(PG8_SA(1, 0), a3, voffA);
            PG8_BAR; PG8_WAIT_L(0); PG8_MMA(1, 0, At, B0); PG8_BAR; PG8_SCHED;
            PG8_STAGE(PG8_SB(1, 1), b3 + hstep, voffB);
            PG8_WAIT_V(6); PG8_BAR; PG8_MMA(1, 1, At, B1); PG8_BAR;
        }
        PG8_STAMP();
        if constexpr (!Epi::AFTER_DRAIN) { E(acc, cur, wr, wc, fr, fq); S.done(cur); }
        PG8_STAMP();
        if (!has_next) break;
        if (!E.keep(cur))
#pragma unroll
        for (int a = 0; a < 2; ++a)
#pragma unroll
            for (int b = 0; b < 2; ++b)
#pragma unroll
                for (int m = 0; m < 4; ++m)
#pragma unroll
                    for (int n = 0; n < 2; ++n) acc[a][b][m][n] = (f32x4){0.f, 0.f, 0.f, 0.f};
        cur = nxt; cA = nA; cB = nB; ++ui;
    }
    PG8_WAIT_V(0);
    if (wr == 0) PG8_BAR;
    PG8_BAR;
    if constexpr (Epi::AFTER_DRAIN) { E.fused(acc, cur, wr, wc, fr, fq, lds, wid, lane); S.done(cur); }
    PG8_STAMP();
    if (STAMP && wid == 0) { stamps[lane] = lane < nts ? (((unsigned long long)(unsigned)ts_hi << 32) | (unsigned)ts_lo) : 0ull;
        if (lane == 62) stamps[62] = rt_entry; if (lane == 63) stamps[63] = (unsigned long long)wall_clock64(); }
#undef PG8_STAMP
#undef PG8_SA
#undef PG8_SB
#undef PG8_STAGE
#undef PG8_LDA
#undef PG8_LDB
#undef PG8_MMA
#undef PG8_WAIT_V
#undef PG8_WAIT_L
#undef PG8_BAR
#undef PG8_SCHED
}
}

using namespace pg8;
namespace cg = cooperative_groups;
#define LAS __attribute__((address_space(3)))
typedef unsigned u32x2 __attribute__((ext_vector_type(2)));

constexpr int T_TOK = 16384, PROJ = 8720, NP = 8704;
constexpr size_t MiB = 1ull << 20;
constexpr size_t OFF_Q = 0, OFF_Z = 32 * MiB, OFF_OG = 64 * MiB, OFF_GA = 96 * MiB, OFF_GM = 128 * MiB, OFF_MV = 160 * MiB,
                 OFF_MQ = 192 * MiB, OFF_MK = 208 * MiB, OFF_K = 224 * MiB, OFF_V = 232 * MiB, OFF_WAT = 240 * MiB,
                 OFF_WOT = 244 * MiB, OFF_IF = 246 * MiB, OFF_BIASP = 247 * MiB, OFF_MLOC = OFF_BIASP + 65536,
                 OFF_GSUM = OFF_MLOC + 8192, OFF_MPREV = OFF_GSUM + 8192, WS_END = OFF_MPREV + 8192;
constexpr size_t OUT_H = 0, OUT_WTIN = 32 * MiB, OUT_CST = 0;
constexpr int LDS_BYTES = 131072;
constexpr int HSZ = 49408;

struct Params {
    const float *x, *norm_w, *w_in, *b_in, *sinks, *conv_w, *conv_b, *mnorm_w, *w_ba, *w_bm, *w_out, *fnorm_w;
    float* out; unsigned char* ws;
    int ph_lo, ph_hi;
};

__device__ __forceinline__ float bf_lo(unsigned w) { return __uint_as_float(w << 16); }
__device__ __forceinline__ float bf_hi(unsigned w) { return __uint_as_float(w & 0xffff0000u); }
__device__ __forceinline__ float bf2f(bf16_t b) { return __uint_as_float(((unsigned)b) << 16); }
__device__ __forceinline__ bf16_t f2bf(float f) { unsigned u = __float_as_uint(f); u += 0x7fffu + ((u >> 16) & 1u); return (bf16_t)(u >> 16); }
__device__ __forceinline__ float sigm(float x) { return 1.f / (1.f + __expf(-x)); }
__device__ __forceinline__ float silu(float x) { return x / (1.f + __expf(-x)); }
__device__ __forceinline__ float wave_sum(float v) {
#pragma unroll
    for (int o = 1; o < 64; o <<= 1) v += __shfl_xor(v, o);
    return v;
}
__device__ __forceinline__ float wave_max(float v) {
#pragma unroll
    for (int o = 1; o < 64; o <<= 1) v = fmaxf(v, __shfl_xor(v, o));
    return v;
}
__device__ __forceinline__ f32x4 mfma16(bf16x8 a, bf16x8 b, f32x4 c) { return __builtin_amdgcn_mfma_f32_16x16x32_bf16(a, b, c, 0, 0, 0); }

__device__ __forceinline__ int src_col(int np) {
    if (np < 4608) return np;
    if (np < 6656) { const int t = (np - 4608) >> 8, r = np & 255; return (r < 128) ? (4624 + 128 * t + r) : (5648 + 128 * t + (r - 128)); }
    return np + 16;
}

__device__ __forceinline__ void transpose_item(const float* W, int N, int n_src0, bf16_t* WT, int row0, int k0, LAS float* scr, int lane) {
#pragma unroll 8
    for (int i = 0; i < 32; ++i) { const int kk = 2 * i + (lane >> 5); scr[kk * 33 + (lane & 31)] = W[(size_t)(k0 + kk) * N + n_src0 + (lane & 31)]; }
    asm volatile("s_waitcnt lgkmcnt(0)" ::: "memory");
    const int c = lane & 7;
#pragma unroll
    for (int j = 0; j < 4; ++j) { const int n = (lane >> 3) + 8 * j; const LAS float* s = scr + (8 * c) * 33 + n;
        u32x4 o; o.x = cvt_pk_bf16(s[0], s[33]); o.y = cvt_pk_bf16(s[66], s[99]); o.z = cvt_pk_bf16(s[132], s[165]); o.w = cvt_pk_bf16(s[198], s[231]);
        *(u32x4*)(WT + (size_t)(row0 + n) * 1024 + k0 + 8 * c) = o; }
    asm volatile("s_waitcnt lgkmcnt(0)" ::: "memory");
}

__device__ __forceinline__ void phase0(const Params& p, LAS unsigned char* lds, int G) {
    const int tid = threadIdx.x, lane = tid & 63, wave = tid >> 6;
    const int gw = blockIdx.x * 8 + wave, NGW = G * 8;
    bf16_t* WtIn = (bf16_t*)((unsigned char*)p.out + OUT_WTIN);
    bf16_t* WaT = (bf16_t*)(p.ws + OFF_WAT);
    bf16_t* WoT = (bf16_t*)(p.ws + OFF_WOT);
    LAS float* scr = (LAS float*)lds + wave * (64 * 33);
    constexpr int I_IN = 16 * (NP / 32), I_SQ = 16 * 32;
    for (int it = gw; it < I_IN + 3 * I_SQ; it += NGW) {
        if (it < I_IN) { const int kb = it / 272, nb = it % 272; transpose_item(p.w_in, PROJ, src_col(nb * 32), WtIn, nb * 32, kb * 64, scr, lane); }
        else { int r = it - I_IN; const int mtx = r / I_SQ; r %= I_SQ; const int kb = r / 32, nb = r % 32;
            const float* W = mtx == 0 ? p.w_ba : (mtx == 1 ? p.w_bm : p.w_out);
            bf16_t* WT = mtx == 2 ? WoT : WaT; const int row0 = (mtx == 1 ? 1024 : 0) + nb * 32;
            transpose_item(W, 1024, nb * 32, WT, row0, kb * 64, scr, lane); }
    }
    float* biasp = (float*)(p.ws + OFF_BIASP);
    for (int i = blockIdx.x * 512 + tid; i < NP; i += G * 512) biasp[i] = p.b_in[src_col(i)];
    __syncthreads();
    LAS float* wgT = (LAS float*)lds;
    for (int idx = tid; idx < 16384; idx += 512) { const int k = idx >> 4, j = idx & 15; wgT[j * 1024 + k] = p.w_in[(size_t)k * PROJ + 4608 + j]; }
    __syncthreads();
    bf16_t* H = (bf16_t*)((unsigned char*)p.out + OUT_H);
    float* IF = (float*)(p.ws + OFF_IF);
    for (int row = gw; row < T_TOK; row += NGW) {
        const f32x4* xr = (const f32x4*)(p.x + (size_t)row * 1024) + lane;
        f32x4 v[4]; float ss = 0.f;
#pragma unroll
        for (int j = 0; j < 4; ++j) { v[j] = xr[64 * j]; ss += (v[j].x * v[j].x + v[j].y * v[j].y) + (v[j].z * v[j].z + v[j].w * v[j].w); }
        ss = wave_sum(ss);
        const float rstd = rsqrtf(ss * (1.f / 1024.f) + 1e-6f);
#pragma unroll
        for (int j = 0; j < 4; ++j) { const f32x4 nw = ((const f32x4*)p.norm_w)[64 * j + lane]; v[j] = v[j] * rstd * nw;
            u32x2 o; o.x = cvt_pk_bf16(v[j].x, v[j].y); o.y = cvt_pk_bf16(v[j].z, v[j].w);
            *((u32x2*)(H + (size_t)row * 1024) + 64 * j + lane) = o; }
        float mine = 0.f;
#pragma unroll
        for (int g = 0; g < 16; ++g) { float pg = 0.f;
#pragma unroll
            for (int j = 0; j < 4; ++j) { const f32x4 w = *(const LAS f32x4*)(wgT + g * 1024 + j * 256 + lane * 4); pg += (v[j].x * w.x + v[j].y * w.y) + (v[j].z * w.z + v[j].w * w.w); }
            pg = wave_sum(pg); mine = (lane == g) ? pg : mine; }
        if (lane < 16) IF[(size_t)row * 16 + lane] = mine + p.b_in[4608 + lane];
    }
}

struct Epi1 {
    static constexpr bool PERM = true, AFTER_DRAIN = false;
    unsigned char* ws; const float* biasp;
    __device__ __forceinline__ bool keep(const Unit&) const { return false; }
    __device__ __forceinline__ void operator()(const f32x4 (&acc)[2][2][4][2], const Unit& u, int wr, int wc, int fr, int fq) const {
        const int pn = u.pn, row0 = u.pm * BM + wr * 64 + fr, lc = wc * 32 + 8 * fq;
        f32x4 bv[2][2];
#pragma unroll
        for (int bj = 0; bj < 2; ++bj)
#pragma unroll
            for (int n = 0; n < 2; ++n) bv[bj][n] = *(const f32x4*)(biasp + pn * 256 + bj * HALF + lc + 4 * n);
        if (pn >= 18 && pn < 26) {
            bf16_t* OG = (bf16_t*)(ws + OFF_OG); const int cb = (pn - 18) * 128 + lc;
#pragma unroll
            for (int ai = 0; ai < 2; ++ai)
#pragma unroll
                for (int m = 0; m < 4; ++m) { float r[8];
#pragma unroll
                    for (int n = 0; n < 2; ++n)
#pragma unroll
                        for (int i = 0; i < 4; ++i) { const float o = acc[ai][0][m][n][i] + bv[0][n][i], z = acc[ai][1][m][n][i] + bv[1][n][i]; r[4 * n + i] = sigm(o) * silu(z); }
                    u32x4 w; w.x = cvt_pk_bf16(r[0], r[1]); w.y = cvt_pk_bf16(r[2], r[3]); w.z = cvt_pk_bf16(r[4], r[5]); w.w = cvt_pk_bf16(r[6], r[7]);
                    *(u32x4*)(OG + (size_t)(row0 + ai * HALF + m * 16) * 1024 + cb) = w; }
            return;
        }
        size_t off; int ld, c0, act;
        if (pn < 4) { off = OFF_Q; ld = 1024; c0 = pn * 256; act = 1; }
        else if (pn == 4) { off = OFF_K; ld = 256; c0 = 0; act = 0; }
        else if (pn == 5) { off = OFF_V; ld = 256; c0 = 0; act = 0; }
        else if (pn < 10) { off = OFF_Z; ld = 1024; c0 = (pn - 6) * 256; act = 2; }
        else if (pn < 12) { off = OFF_MQ; ld = 512; c0 = (pn - 10) * 256; act = 0; }
        else if (pn < 14) { off = OFF_MK; ld = 512; c0 = (pn - 12) * 256; act = 0; }
        else if (pn < 18) { off = OFF_MV; ld = 1024; c0 = (pn - 14) * 256; act = 0; }
        else if (pn < 30) { off = OFF_GA; ld = 1024; c0 = (pn - 26) * 256; act = 3; }
        else { off = OFF_GM; ld = 1024; c0 = (pn - 30) * 256; act = 3; }
        bf16_t* dst = (bf16_t*)(ws + off) + c0 + lc;
#pragma unroll
        for (int ai = 0; ai < 2; ++ai)
#pragma unroll
            for (int m = 0; m < 4; ++m) { bf16_t* rowp = dst + (size_t)(row0 + ai * HALF + m * 16) * ld;
#pragma unroll
                for (int bj = 0; bj < 2; ++bj) { f32x4 v0 = acc[ai][bj][m][0] + bv[bj][0], v1 = acc[ai][bj][m][1] + bv[bj][1];
                    if (act == 1) { v0 = v0 * 0.125f; v1 = v1 * 0.125f; }
                    else if (act == 2) {
#pragma unroll
                        for (int i = 0; i < 4; ++i) { v0[i] = silu(v0[i]); v1[i] = silu(v1[i]); } }
                    else if (act == 3) {
#pragma unroll
                        for (int i = 0; i < 4; ++i) { v0[i] = sigm(v0[i]); v1[i] = sigm(v1[i]); } }
                    u32x4 w; w.x = cvt_pk_bf16(v0[0], v0[1]); w.y = cvt_pk_bf16(v0[2], v0[3]); w.z = cvt_pk_bf16(v1[0], v1[1]); w.w = cvt_pk_bf16(v1[2], v1[3]);
                    *(u32x4*)(rowp + bj * HALF) = w; } }
    }
};

__device__ __forceinline__ void attn_item(const Params& p, LAS unsigned char* lds, int it) {
    const int tid = threadIdx.x, lane = tid & 63, wave = tid >> 6, fr = lane & 15, fq = lane >> 4;
    const int b = it >> 7, kvh = (it >> 5) & 3, qb = it & 31, t0 = b * 4096 + qb * 128;
    LAS bf16_t* Ks = (LAS bf16_t*)lds;
    LAS bf16_t* Vt = Ks + 256 * 72;
    const bf16_t* Kb = (const bf16_t*)(p.ws + OFF_K); const bf16_t* Vb = (const bf16_t*)(p.ws + OFF_V);
    const bf16_t* Q = (const bf16_t*)(p.ws + OFF_Q); bf16_t* Z = (bf16_t*)(p.ws + OFF_Z);
#pragma unroll
    for (int i = 0; i < 4; ++i) { const int c = tid + 512 * i, j = c >> 3, dc = c & 7;
        u32x4 kv = {0u, 0u, 0u, 0u}, vv = {0u, 0u, 0u, 0u};
        if (qb > 0 || j >= 128) { const size_t off = (size_t)(t0 - 128 + j) * 256 + kvh * 64 + dc * 8; kv = *(const u32x4*)(Kb + off); vv = *(const u32x4*)(Vb + off); }
        *(LAS u32x4*)(Ks + j * 72 + dc * 8) = kv;
        LAS bf16_t* vp = Vt + (dc * 8) * 264 + j;
        vp[0] = (bf16_t)(vv.x & 0xffffu); vp[264] = (bf16_t)(vv.x >> 16); vp[2 * 264] = (bf16_t)(vv.y & 0xffffu); vp[3 * 264] = (bf16_t)(vv.y >> 16);
        vp[4 * 264] = (bf16_t)(vv.z & 0xffffu); vp[5 * 264] = (bf16_t)(vv.z >> 16); vp[6 * 264] = (bf16_t)(vv.w & 0xffffu); vp[7 * 264] = (bf16_t)(vv.w >> 16); }
    __syncthreads();
    const int g = wave & 3, half = wave >> 2, hq = kvh * 4 + g; const float sink = p.sinks[hq];
    for (int qc = 0; qc < 2; ++qc) {
        const int i0 = half * 64 + qc * 32;
        bf16x8 qf[2][2];
#pragma unroll
        for (int qs = 0; qs < 2; ++qs)
#pragma unroll
            for (int ks = 0; ks < 2; ++ks) qf[qs][ks] = *(const bf16x8*)(Q + (size_t)(t0 + i0 + qs * 16 + fr) * 1024 + hq * 64 + ks * 32 + fq * 8);
        f32x4 s[10][2];
#pragma unroll
        for (int kt = 0; kt < 10; ++kt) { s[kt][0] = (f32x4){0.f, 0.f, 0.f, 0.f}; s[kt][1] = (f32x4){0.f, 0.f, 0.f, 0.f};
#pragma unroll
            for (int ks = 0; ks < 2; ++ks) { const bf16x8 kf = *(const LAS bf16x8*)(Ks + (i0 + kt * 16 + fr) * 72 + ks * 32 + fq * 8);
                s[kt][0] = mfma16(kf, qf[0][ks], s[kt][0]); s[kt][1] = mfma16(kf, qf[1][ks], s[kt][1]); } }
        float mx[2] = {sink, sink};
#pragma unroll
        for (int kt = 0; kt < 10; ++kt)
#pragma unroll
            for (int qs = 0; qs < 2; ++qs)
#pragma unroll
                for (int r = 0; r < 4; ++r) { const int j = i0 + kt * 16 + fq * 4 + r, i = i0 + qs * 16 + fr;
                    const bool ok = (j > i) && (j <= i + 128) && (qb > 0 || j >= 128);
                    const float sv = ok ? s[kt][qs][r] : -INFINITY; s[kt][qs][r] = sv; mx[qs] = fmaxf(mx[qs], sv); }
        float inv[2];
#pragma unroll
        for (int qs = 0; qs < 2; ++qs) { mx[qs] = fmaxf(mx[qs], __shfl_xor(mx[qs], 16)); mx[qs] = fmaxf(mx[qs], __shfl_xor(mx[qs], 32)); }
        float sum[2] = {0.f, 0.f};
#pragma unroll
        for (int kt = 0; kt < 10; ++kt)
#pragma unroll
            for (int qs = 0; qs < 2; ++qs)
#pragma unroll
                for (int r = 0; r < 4; ++r) { const float pv = __expf(s[kt][qs][r] - mx[qs]); s[kt][qs][r] = pv; sum[qs] += pv; }
#pragma unroll
        for (int qs = 0; qs < 2; ++qs) { sum[qs] += __shfl_xor(sum[qs], 16); sum[qs] += __shfl_xor(sum[qs], 32); inv[qs] = 1.f / (sum[qs] + __expf(sink - mx[qs])); }
        f32x4 o[4][2];
#pragma unroll
        for (int dt = 0; dt < 4; ++dt) { o[dt][0] = (f32x4){0.f, 0.f, 0.f, 0.f}; o[dt][1] = (f32x4){0.f, 0.f, 0.f, 0.f}; }
#pragma unroll
        for (int kp = 0; kp < 5; ++kp) {
            bf16x8 pf[2];
#pragma unroll
            for (int qs = 0; qs < 2; ++qs) { u32x4 w; w.x = cvt_pk_bf16(s[2 * kp][qs][0], s[2 * kp][qs][1]); w.y = cvt_pk_bf16(s[2 * kp][qs][2], s[2 * kp][qs][3]);
                w.z = cvt_pk_bf16(s[2 * kp + 1][qs][0], s[2 * kp + 1][qs][1]); w.w = cvt_pk_bf16(s[2 * kp + 1][qs][2], s[2 * kp + 1][qs][3]); pf[qs] = __builtin_bit_cast(bf16x8, w); }
#pragma unroll
            for (int dt = 0; dt < 4; ++dt) { const LAS bf16_t* vp = Vt + (dt * 16 + fr) * 264 + i0 + kp * 32 + fq * 4;
                const u32x2 a0 = *(const LAS u32x2*)vp, a1 = *(const LAS u32x2*)(vp + 16);
                u32x4 aw; aw.x = a0.x; aw.y = a0.y; aw.z = a1.x; aw.w = a1.y; const bf16x8 vf = __builtin_bit_cast(bf16x8, aw);
                o[dt][0] = mfma16(vf, pf[0], o[dt][0]); o[dt][1] = mfma16(vf, pf[1], o[dt][1]); } }
#pragma unroll
        for (int qs = 0; qs < 2; ++qs)
#pragma unroll
            for (int dt = 0; dt < 4; ++dt) { bf16_t* zp = Z + (size_t)(t0 + i0 + qs * 16 + fr) * 1024 + hq * 64 + dt * 16 + fq * 4;
                const u32x2 zz = *(const u32x2*)zp; u32x2 w;
                w.x = cvt_pk_bf16(o[dt][qs][0] * inv[qs] * bf_lo(zz.x), o[dt][qs][1] * inv[qs] * bf_hi(zz.x));
                w.y = cvt_pk_bf16(o[dt][qs][2] * inv[qs] * bf_lo(zz.y), o[dt][qs][3] * inv[qs] * bf_hi(zz.y));
                *(u32x2*)zp = w; }
    }
    __syncthreads();
}

__device__ __forceinline__ void mlstm_gates(const float* IF, int ts, int hh, int lane, float& bcum, float& ig) {
    const float f = IF[(size_t)(ts + lane) * 16 + 8 + hh]; ig = IF[(size_t)(ts + lane) * 16 + hh];
    float lf = fminf(f, 0.f) - log1pf(expf(-fabsf(f)));
#pragma unroll
    for (int o = 1; o < 64; o <<= 1) { const float t = __shfl_up(lf, o); if (lane >= o) lf += t; }
    bcum = lf;
}
__device__ __forceinline__ void conv8(const Params& p, const bf16_t* U, int t, int pos, int cch, int bcol, float (&o)[8]) {
    const f32x4* cb = (const f32x4*)(p.conv_b + cch); const f32x4 b0 = cb[0], b1 = cb[1];
    o[0] = b0.x; o[1] = b0.y; o[2] = b0.z; o[3] = b0.w; o[4] = b1.x; o[5] = b1.y; o[6] = b1.z; o[7] = b1.w;
#pragma unroll
    for (int j = 0; j < 4; ++j) {
        if (pos - 3 + j >= 0) { const u32x4 w = *(const u32x4*)(U + (size_t)(t - 3 + j) * 512 + bcol);
            const f32x4* cw = (const f32x4*)(p.conv_w + j * 1024 + cch); const f32x4 w0 = cw[0], w1 = cw[1];
            o[0] += w0.x * bf_lo(w.x); o[1] += w0.y * bf_hi(w.x); o[2] += w0.z * bf_lo(w.y); o[3] += w0.w * bf_hi(w.y);
            o[4] += w1.x * bf_lo(w.z); o[5] += w1.y * bf_hi(w.z); o[6] += w1.z * bf_lo(w.w); o[7] += w1.w * bf_hi(w.w); } }
}
__device__ __forceinline__ void stage_vt(const Params& p, LAS bf16_t* Vt, int ts, int hh, int hl) {
    const bf16_t* MV = (const bf16_t*)(p.ws + OFF_MV);
#pragma unroll
    for (int i = 0; i < 4; ++i) { const int task = hl + 256 * i, vg = task & 15, l = task >> 4;
        const u32x4 vv = *(const u32x4*)(MV + (size_t)(ts + l) * 1024 + hh * 128 + vg * 8);
        LAS bf16_t* vp = Vt + (vg * 8) * 72 + l;
        vp[0] = (bf16_t)(vv.x & 0xffffu); vp[72] = (bf16_t)(vv.x >> 16); vp[2 * 72] = (bf16_t)(vv.y & 0xffffu); vp[3 * 72] = (bf16_t)(vv.y >> 16);
        vp[4 * 72] = (bf16_t)(vv.z & 0xffffu); vp[5 * 72] = (bf16_t)(vv.z >> 16); vp[6 * 72] = (bf16_t)(vv.w & 0xffffu); vp[7 * 72] = (bf16_t)(vv.w >> 16); }
#pragma unroll
    for (int i = 0; i < 4; ++i) { const int idx = hl + 256 * i, r = 128 + (idx >> 6), l = idx & 63; Vt[r * 72 + l] = (r == 128) ? (bf16_t)0x3F80u : (bf16_t)0u; }
}

__device__ __forceinline__ void mlstm_pass1(const Params& p, LAS unsigned char* lds, int itp) {
    const int tid = threadIdx.x, lane = tid & 63, wave = tid >> 6, fr = lane & 15, fq = lane >> 4;
    const int sub = wave >> 2, hw = wave & 3, hl = tid & 255;
    const int item = 2 * itp + sub, b = item >> 9, hh = (item >> 6) & 7, c = item & 63, ts = b * 4096 + c * 64;
    LAS unsigned char* base = lds + sub * HSZ;
    LAS float* wts = (LAS float*)base;
    LAS bf16_t* Kwt = (LAS bf16_t*)(base + 2048);
    LAS bf16_t* Vt = Kwt + 64 * 72;
    const float* IF = (const float*)(p.ws + OFF_IF);
    if (hw == 0) { float bc, ig; mlstm_gates(IF, ts, hh, lane, bc, ig);
        const float gs = __shfl(bc, 63), a = gs - bc + ig, ml = wave_max(a);
        wts[lane] = expf(a - ml);
        if (lane == 0) { ((float*)(p.ws + OFF_MLOC))[item] = ml; ((float*)(p.ws + OFF_GSUM))[item] = gs; } }
    __syncthreads();
    const bf16_t* MK = (const bf16_t*)(p.ws + OFF_MK);
#pragma unroll
    for (int i = 0; i < 2; ++i) { const int task = hl + 256 * i, kg = task & 7, l = task >> 3;
        float kc[8]; conv8(p, MK, ts + l, c * 64 + l, 512 + hh * 64 + kg * 8, hh * 64 + kg * 8, kc);
        const float w = wts[l]; LAS bf16_t* kp = Kwt + (kg * 8) * 72 + l;
#pragma unroll
        for (int e = 0; e < 8; ++e) kp[e * 72] = f2bf(silu(kc[e]) * w); }
    stage_vt(p, Vt, ts, hh, hl);
    __syncthreads();
    f32x4 acc[9];
#pragma unroll
    for (int vt = 0; vt < 9; ++vt) acc[vt] = (f32x4){0.f, 0.f, 0.f, 0.f};
#pragma unroll
    for (int ks = 0; ks < 2; ++ks) { const bf16x8 bf = *(const LAS bf16x8*)(Kwt + (hw * 16 + fr) * 72 + ks * 32 + fq * 8);
#pragma unroll
        for (int vt = 0; vt < 9; ++vt) { const bf16x8 af = *(const LAS bf16x8*)(Vt + (vt * 16 + fr) * 72 + ks * 32 + fq * 8); acc[vt] = mfma16(af, bf, acc[vt]); } }
    bf16_t* cst = (bf16_t*)((unsigned char*)p.out + OUT_CST) + (size_t)item * 9216;
#pragma unroll
    for (int vt = 0; vt < 9; ++vt)
#pragma unroll
        for (int r = 0; r < 4; ++r) cst[(vt * 16 + fq * 4 + r) * 64 + hw * 16 + fr] = f2bf(acc[vt][r]);
    __syncthreads();
}

__device__ __forceinline__ void mlstm_scan(const Params& p, int G) {
    const float* mloc = (const float*)(p.ws + OFF_MLOC); const float* gsum = (const float*)(p.ws + OFF_GSUM); float* mprev = (float*)(p.ws + OFF_MPREV);
    bf16_t* cst = (bf16_t*)((unsigned char*)p.out + OUT_CST);
    for (int task = blockIdx.x * 512 + threadIdx.x; task < 32 * 2304; task += G * 512) {
        const int bh = task / 2304, e = task % 2304;
        float s0 = 0.f, s1 = 0.f, s2 = 0.f, s3 = 0.f, m = -1e30f;
        u32x2* ptr = (u32x2*)(cst + (size_t)bh * 64 * 9216 + e * 4);
#pragma unroll 4
        for (int c = 0; c < 64; ++c) { const float gl = gsum[bh * 64 + c], ml = mloc[bh * 64 + c];
            const u32x2 cl = *ptr; u32x2 w; w.x = cvt_pk_bf16(s0, s1); w.y = cvt_pk_bf16(s2, s3); *ptr = w;
            if (e == 0) mprev[bh * 64 + c] = m;
            const float mn = fmaxf(gl + m, ml), sp = expf(gl + m - mn), sl = expf(ml - mn);
            s0 = sp * s0 + sl * bf_lo(cl.x); s1 = sp * s1 + sl * bf_hi(cl.x); s2 = sp * s2 + sl * bf_lo(cl.y); s3 = sp * s3 + sl * bf_hi(cl.y);
            m = mn; ptr += 9216 / 4; }
    }
}

__device__ __forceinline__ void mlstm_pass3(const Params& p, LAS unsigned char* lds, int itp) {
    const int tid = threadIdx.x, lane = tid & 63, wave = tid >> 6, fr = lane & 15, fq = lane >> 4;
    const int sub = wave >> 2, hw = wave & 3, hl = tid & 255;
    const int item = 2 * itp + sub, b = item >> 9, hh = (item >> 6) & 7, c = item & 63, ts = b * 4096 + c * 64;
    LAS unsigned char* base = lds + sub * HSZ;
    LAS float* fb = (LAS float*)base; LAS float* fu = fb + 64; LAS float* fM = fb + 128; LAS float* fI = fb + 192;
    LAS bf16_t* Ks = (LAS bf16_t*)(base + 2048);
    LAS bf16_t* Vt = Ks + 64 * 72;
    LAS bf16_t* A = Vt + 144 * 72;
    const float* IF = (const float*)(p.ws + OFF_IF);
    if (hw == 0) { float bc, ig; mlstm_gates(IF, ts, hh, lane, bc, ig);
        const float u = ig - bc; float pm = u;
#pragma unroll
        for (int o = 1; o < 64; o <<= 1) { const float t = __shfl_up(pm, o); if (lane >= o) pm = fmaxf(pm, t); }
        const float mp = ((const float*)(p.ws + OFF_MPREV))[item], M = fmaxf(mp, pm);
        fb[lane] = bc; fu[lane] = u; fM[lane] = M; fI[lane] = expf(mp - M); }
    const bf16_t* MQ = (const bf16_t*)(p.ws + OFF_MQ); const bf16_t* MK = (const bf16_t*)(p.ws + OFF_MK);
#pragma unroll
    for (int i = 0; i < 2; ++i) { const int task = hl + 256 * i, kg = task & 7, l = task >> 3;
        float qc[8], kc[8];
        conv8(p, MQ, ts + l, c * 64 + l, hh * 64 + kg * 8, hh * 64 + kg * 8, qc);
        conv8(p, MK, ts + l, c * 64 + l, 512 + hh * 64 + kg * 8, hh * 64 + kg * 8, kc);
        u32x4 wq, wk;
        wq.x = cvt_pk_bf16(0.125f * silu(qc[0]), 0.125f * silu(qc[1])); wq.y = cvt_pk_bf16(0.125f * silu(qc[2]), 0.125f * silu(qc[3]));
        wq.z = cvt_pk_bf16(0.125f * silu(qc[4]), 0.125f * silu(qc[5])); wq.w = cvt_pk_bf16(0.125f * silu(qc[6]), 0.125f * silu(qc[7]));
        wk.x = cvt_pk_bf16(silu(kc[0]), silu(kc[1])); wk.y = cvt_pk_bf16(silu(kc[2]), silu(kc[3]));
        wk.z = cvt_pk_bf16(silu(kc[4]), silu(kc[5])); wk.w = cvt_pk_bf16(silu(kc[6]), silu(kc[7]));
        *(LAS u32x4*)(A + l * 136 + 64 + kg * 8) = wq; *(LAS u32x4*)(Ks + l * 72 + kg * 8) = wk; }
    stage_vt(p, Vt, ts, hh, hl);
    __syncthreads();
    f32x4 sa[4];
#pragma unroll
    for (int st = 0; st < 4; ++st) sa[st] = (f32x4){0.f, 0.f, 0.f, 0.f};
#pragma unroll
    for (int ks = 0; ks < 2; ++ks) { const bf16x8 af = *(const LAS bf16x8*)(A + (hw * 16 + fr) * 136 + 64 + ks * 32 + fq * 8);
#pragma unroll
        for (int st = 0; st < 4; ++st) { const bf16x8 bf = *(const LAS bf16x8*)(Ks + (st * 16 + fr) * 72 + ks * 32 + fq * 8); sa[st] = mfma16(af, bf, sa[st]); } }
#pragma unroll
    for (int st = 0; st < 4; ++st)
#pragma unroll
        for (int r = 0; r < 4; ++r) { const int l = hw * 16 + fq * 4 + r, s = st * 16 + fr;
            const float val = (s <= l) ? sa[st][r] * expf(fu[s] - fM[l]) : 0.f; A[l * 136 + s] = f2bf(val); }
    __syncthreads();
    f32x4 ai[9], ae[9];
#pragma unroll
    for (int vt = 0; vt < 9; ++vt) { ai[vt] = (f32x4){0.f, 0.f, 0.f, 0.f}; ae[vt] = (f32x4){0.f, 0.f, 0.f, 0.f}; }
    const bf16_t* cst = (const bf16_t*)((unsigned char*)p.out + OUT_CST) + (size_t)item * 9216;
#pragma unroll
    for (int ks = 0; ks < 2; ++ks) {
        const bf16x8 a1 = *(const LAS bf16x8*)(A + (hw * 16 + fr) * 136 + ks * 32 + fq * 8), a2 = *(const LAS bf16x8*)(A + (hw * 16 + fr) * 136 + 64 + ks * 32 + fq * 8);
#pragma unroll
        for (int vt = 0; vt < 9; ++vt) { const bf16x8 b1 = *(const LAS bf16x8*)(Vt + (vt * 16 + fr) * 72 + ks * 32 + fq * 8); ai[vt] = mfma16(a1, b1, ai[vt]);
            const bf16x8 b2 = *(const bf16x8*)(cst + (vt * 16 + fr) * 64 + ks * 32 + fq * 8); ae[vt] = mfma16(a2, b2, ae[vt]); } }
    bf16_t* OG = (bf16_t*)(p.ws + OFF_OG);
#pragma unroll
    for (int r = 0; r < 4; ++r) { const int l = hw * 16 + fq * 4 + r; const float inter = fI[l];
        float num[9];
#pragma unroll
        for (int vt = 0; vt < 9; ++vt) num[vt] = ai[vt][r] + inter * ae[vt][r];
        const float den = __shfl(num[8], lane & 48);
        const float rD = 1.f / fmaxf(fabsf(den), expf(-(fb[l] + fM[l])));
        float ss = 0.f;
#pragma unroll
        for (int vt = 0; vt < 8; ++vt) { num[vt] *= rD; ss += num[vt] * num[vt]; }
        ss += __shfl_xor(ss, 1); ss += __shfl_xor(ss, 2); ss += __shfl_xor(ss, 4); ss += __shfl_xor(ss, 8);
        const float rs = rsqrtf(ss * (1.f / 128.f) + 1e-6f);
#pragma unroll
        for (int vt = 0; vt < 8; ++vt) { const int v = vt * 16 + fr; const size_t idx = (size_t)(ts + l) * 1024 + hh * 128 + v;
            OG[idx] = f2bf(bf2f(OG[idx]) * num[vt] * rs * p.mnorm_w[hh * 128 + v]); } }
    __syncthreads();
}

struct PairOrder {
    StaticOrder so;
    __device__ bool next(int i, Unit& u) const { if (!so.next(i >> 1, u)) return false; if (i & 1) { u.pm += 64; u.pn += 4; } return true; }
    __device__ __forceinline__ void a_ready(const Unit&) const {}
    __device__ __forceinline__ void done(const Unit&) const {}
};
struct EpiMerge {
    static constexpr bool PERM = true, AFTER_DRAIN = false;
    const bf16_t *GA, *GM; bf16_t* Mg;
    __device__ __forceinline__ bool keep(const Unit& u) const { return u.pn < 4; }
    __device__ __forceinline__ void operator()(f32x4 (&acc)[2][2][4][2], const Unit& u, int wr, int wc, int fr, int fq) const {
        const bool first = u.pn < 4; const int pm = first ? u.pm : u.pm - 64, pn = first ? u.pn : u.pn - 4;
        const int row0 = pm * BM + wr * 64 + fr, col0 = pn * BM + wc * 32 + 8 * fq;
#pragma unroll
        for (int ai = 0; ai < 2; ++ai)
#pragma unroll
            for (int m = 0; m < 4; ++m)
#pragma unroll
                for (int bj = 0; bj < 2; ++bj) { const size_t idx = (size_t)(row0 + ai * HALF + m * 16) * 1024 + col0 + bj * HALF;
                    const u32x4 gm = *(const u32x4*)(GM + idx);
                    float gmf[8] = {bf_lo(gm.x), bf_hi(gm.x), bf_lo(gm.y), bf_hi(gm.y), bf_lo(gm.z), bf_hi(gm.z), bf_lo(gm.w), bf_hi(gm.w)};
                    if (first) { const u32x4 ga = *(const u32x4*)(GA + idx);
                        float gaf[8] = {bf_lo(ga.x), bf_hi(ga.x), bf_lo(ga.y), bf_hi(ga.y), bf_lo(ga.z), bf_hi(ga.z), bf_lo(ga.w), bf_hi(ga.w)};
#pragma unroll
                        for (int i = 0; i < 4; ++i) { acc[ai][bj][m][0][i] *= gaf[i] / gmf[i]; acc[ai][bj][m][1][i] *= gaf[4 + i] / gmf[4 + i]; } }
                    else { u32x4 w;
                        w.x = cvt_pk_bf16(acc[ai][bj][m][0][0] * gmf[0], acc[ai][bj][m][0][1] * gmf[1]); w.y = cvt_pk_bf16(acc[ai][bj][m][0][2] * gmf[2], acc[ai][bj][m][0][3] * gmf[3]);
                        w.z = cvt_pk_bf16(acc[ai][bj][m][1][0] * gmf[4], acc[ai][bj][m][1][1] * gmf[5]); w.w = cvt_pk_bf16(acc[ai][bj][m][1][2] * gmf[6], acc[ai][bj][m][1][3] * gmf[7]);
                        *(u32x4*)(Mg + idx) = w; } }
    }
};
struct EpiOut {
    static constexpr bool PERM = false, AFTER_DRAIN = false;
    const float* x; float* out;
    __device__ __forceinline__ bool keep(const Unit&) const { return false; }
    __device__ __forceinline__ void operator()(const f32x4 (&acc)[2][2][4][2], const Unit& u, int wr, int wc, int fr, int fq) const {
        const int row0 = u.pm * BM + wr * 64 + fr, col0 = u.pn * BM + wc * 32 + 4 * fq;
#pragma unroll
        for (int ai = 0; ai < 2; ++ai)
#pragma unroll
            for (int m = 0; m < 4; ++m) { const size_t ro = (size_t)(row0 + ai * HALF + m * 16) * 1024 + col0;
#pragma unroll
                for (int bj = 0; bj < 2; ++bj)
#pragma unroll
                    for (int n = 0; n < 2; ++n) { const f32x4 xv = *(const f32x4*)(x + ro + bj * HALF + n * 16); *(f32x4*)(out + ro + bj * HALF + n * 16) = acc[ai][bj][m][n] + xv; } }
    }
};

__global__ void __launch_bounds__(512, 2) mega(Params p) {
    extern __shared__ __attribute__((aligned(16))) unsigned char shm[];
    LAS unsigned char* lds = (LAS unsigned char*)shm;
    cg::grid_group grid = cg::this_grid();
    const int G = gridDim.x;
#define PHASE(n) if (p.ph_lo <= (n) && (n) < p.ph_hi)
#define SEAM(n) if (p.ph_lo < (n) && (n) < p.ph_hi) grid.sync();
    PHASE(0) phase0(p, lds, G);
    SEAM(1)
    PHASE(1) {
        Gemm g; g.A = (const bf16_t*)((unsigned char*)p.out + OUT_H); g.Bt = (const bf16_t*)((unsigned char*)p.out + OUT_WTIN); g.M = T_TOK; g.N = NP; g.K = 1024;
        StaticOrder S; S.init(T_TOK, NP, G, blockIdx.x);
        Epi1 E; E.ws = p.ws; E.biasp = (const float*)(p.ws + OFF_BIASP);
        gemm_phase<Epi1, StaticOrder>(lds, g, S, E, nullptr);
    }
    SEAM(2)
    PHASE(2) {
        for (int it = blockIdx.x; it < 512; it += G) attn_item(p, lds, it);
        for (int itp = blockIdx.x; itp < 1024; itp += G) mlstm_pass1(p, lds, itp);
    }
    SEAM(3)
    PHASE(3) mlstm_scan(p, G);
    SEAM(4)
    PHASE(4) { for (int itp = blockIdx.x; itp < 1024; itp += G) mlstm_pass3(p, lds, itp); }
    SEAM(5)
    PHASE(5) {
        Gemm g; g.A = (const bf16_t*)(p.ws + OFF_Z); g.Bt = (const bf16_t*)(p.ws + OFF_WAT); g.M = T_TOK; g.N = 1024; g.K = 1024;
        PairOrder S; S.so.init(T_TOK, 1024, G, blockIdx.x);
        EpiMerge E; E.GA = (const bf16_t*)(p.ws + OFF_GA); E.GM = (const bf16_t*)(p.ws + OFF_GM); E.Mg = (bf16_t*)(p.ws + OFF_Q);
        gemm_phase<EpiMerge, PairOrder>(lds, g, S, E, nullptr);
    }
    SEAM(6)
    PHASE(6) {
        Gemm g; g.A = (const bf16_t*)(p.ws + OFF_Q); g.Bt = (const bf16_t*)(p.ws + OFF_WOT); g.M = T_TOK; g.N = 1024; g.K = 1024;
        StaticOrder S; S.init(T_TOK, 1024, G, blockIdx.x);
        EpiOut E; E.x = p.x; E.out = p.out;
        gemm_phase<EpiOut, StaticOrder>(lds, g, S, E, nullptr);
    }
    SEAM(7)
    PHASE(7) {
        const int lane = threadIdx.x & 63, gw = blockIdx.x * 8 + (threadIdx.x >> 6);
        for (int row = gw; row < T_TOK; row += G * 8) {
            f32x4* xr = (f32x4*)(p.out + (size_t)row * 1024) + lane;
            f32x4 v[4]; float ss = 0.f;
#pragma unroll
            for (int j = 0; j < 4; ++j) { v[j] = xr[64 * j]; ss += (v[j].x * v[j].x + v[j].y * v[j].y) + (v[j].z * v[j].z + v[j].w * v[j].w); }
            ss = wave_sum(ss);
            const float rstd = rsqrtf(ss * (1.f / 1024.f) + 1e-6f);
#pragma unroll
            for (int j = 0; j < 4; ++j) { const f32x4 nw = ((const f32x4*)p.fnorm_w)[64 * j + lane]; xr[64 * j] = v[j] * rstd * nw; }
        }
    }
}

extern "C" void kernel_launch(void* const* d_in, const int* in_sizes, int n_in, void* d_out, int out_size, void* d_ws, size_t ws_size, hipStream_t stream) {
    static int grid = 0;
    if (grid == 0) {
        if (n_in != 12 || out_size != T_TOK * 1024 || ws_size < WS_END) { fprintf(stderr, "kernel_launch: unexpected shapes (n_in %d out %d ws %zu)\n", n_in, out_size, ws_size); grid = -1; return; }
        int dev = 0, cus = 0, per_cu = 0;
        hipGetDevice(&dev); hipDeviceGetAttribute(&cus, hipDeviceAttributeMultiprocessorCount, dev);
        if (hipFuncSetAttribute((const void*)mega, hipFuncAttributeMaxDynamicSharedMemorySize, LDS_BYTES) != hipSuccess) { fprintf(stderr, "kernel_launch: hipFuncSetAttribute failed\n"); grid = -1; return; }
        if (hipOccupancyMaxActiveBlocksPerMultiprocessor(&per_cu, (const void*)mega, 512, LDS_BYTES) != hipSuccess || per_cu < 1) { fprintf(stderr, "kernel_launch: occupancy query failed (%d)\n", per_cu); grid = -1; return; }
        grid = cus * per_cu;
    }
    if (grid < 0) return;
    Params p{};
    p.x = (const float*)d_in[0]; p.norm_w = (const float*)d_in[1]; p.w_in = (const float*)d_in[2]; p.b_in = (const float*)d_in[3]; p.sinks = (const float*)d_in[4];
    p.conv_w = (const float*)d_in[5]; p.conv_b = (const float*)d_in[6]; p.mnorm_w = (const float*)d_in[7]; p.w_ba = (const float*)d_in[8]; p.w_bm = (const float*)d_in[9];
    p.w_out = (const float*)d_in[10]; p.fnorm_w = (const float*)d_in[11];
    p.out = (float*)d_out; p.ws = (unsigned char*)d_ws; p.ph_lo = 0; p.ph_hi = 8;
    void* args[] = {&p};
    hipError_t e = hipLaunchCooperativeKernel((const void*)mega, dim3(grid), dim3(512), args, LDS_BYTES, stream);
    if (e != hipSuccess) fprintf(stderr, "kernel_launch: cooperative launch failed: %s (grid %d)\n", hipGetErrorString(e), grid);
}
```

```cpp
#include <hip/hip_runtime.h>
#include <cstdio>
#include <cmath>
namespace pg8 {
#define PG8_LAS __attribute__((address_space(3)))
typedef unsigned short bf16_t;
typedef short bf16x8 __attribute__((ext_vector_type(8)));
typedef float f32x4 __attribute__((ext_vector_type(4)));
typedef unsigned u32x4 __attribute__((ext_vector_type(4)));
constexpr int BM = 256, BK = 64, HALF = 128, HTB = HALF * BK * 2  , STAGE_BYTES = 8 * HTB, NXCD = 8, WGM = 8;

__host__ __device__ __forceinline__ int lds_byte(int r, int c) { const int st = (r >> 4) * 2 + (c >> 5), rr = r & 15, cc = c & 31, ob = rr * 64 + cc * 2; return st * 1024 + (ob ^ (((ob >> 9) & 1) << 5)); }
__host__ __device__ __forceinline__ void stage_rc(int b, int& R, int& C) { const int st = b / 1024, sb = b % 1024, swz = sb ^ (((sb >> 9) & 1) << 5); R = (st >> 1) * 16 + swz / 64; C = (st & 1) * 32 + (swz % 64) / 2; }
__host__ __device__ __forceinline__ int perm32(int rho) { const int n = rho >> 4, i = rho & 15; return 8 * (i >> 2) + 4 * n + (i & 3); }

struct Unit { int pm, pn; };
struct Gemm { const bf16_t* A; const bf16_t* Bt; int M, N, K; };

struct StaticOrder {
    int nM, nN, nwg, G, c;
    __host__ __device__ void init(int M, int N, int G_, int c_) { nM = M / BM; nN = N / BM; nwg = nM * nN; G = G_; c = c_; }
    __host__ __device__ bool next(int i, Unit& u) const {
        const long L = (long)i * G + c; if (L >= nwg) return false;
        int wgid = (int)L; { const int q = nwg / NXCD, r = nwg % NXCD, xcd = wgid % NXCD, off = wgid / NXCD; wgid = (xcd < r ? xcd * (q + 1) : r * (q + 1) + (xcd - r) * q) + off; }
        const int nig = WGM * nN, gid = wgid / nig, fm = gid * WGM, gsz = (nM - fm) < WGM ? (nM - fm) : WGM;
        u.pm = fm + ((wgid % nig) % gsz); u.pn = (wgid % nig) / gsz; return true;
    }
    __device__ __forceinline__ void a_ready(const Unit&) const {}
    __device__ __forceinline__ void done(const Unit&) const {}
};
__device__ __forceinline__ unsigned cvt_pk_bf16(float lo, float hi) { unsigned r; asm volatile("v_cvt_pk_bf16_f32 %0, %1, %2" : "=v"(r) : "v"(lo), "v"(hi)); return r; }
template <class Epi, class Sched, bool ALIGN_EPI = false, bool SP2 = false>
__device__ __forceinline__ void gemm_phase(PG8_LAS unsigned char* lds, const Gemm g, const Sched& S, const Epi& E) {
    const int tid = threadIdx.x, wid = __builtin_amdgcn_readfirstlane(tid >> 6), lane = tid & 63, wr = wid >> 2, wc = wid & 3, fr = lane & 15, fq = lane >> 4;
    const int K = g.K, nt = K / BK;
    unsigned voffA[2], voffB[2];
#pragma unroll
    for (int i = 0; i < 2; ++i) { int R, C; stage_rc(tid * 16 + i * 8192, R, C); const int Rb = Epi::PERM ? ((R & ~31) + perm32(R & 31)) : R;
        voffA[i] = (unsigned)(R * K + C) * 2u; voffB[i] = (unsigned)(Rb * K + C) * 2u; }
    const size_t kstep = (size_t)(BK * 2);
    const size_t hstep = (size_t)HALF * K * 2;
    const size_t tstep = 2 * hstep;
    const unsigned ldsw = (unsigned)wid * 1024u;
    const int aoff = lds_byte(wr * 64 + fr, fq * 8), boff = lds_byte(wc * 32 + fr, fq * 8);
#define PG8_SA(b, h) (((b) * 2 + (h)) * HTB)
#define PG8_SB(b, h) ((4 + (b) * 2 + (h)) * HTB)
#define PG8_STAGE(bufoff, gbase, voff) do { _Pragma("unroll") for (int _i = 0; _i < 2; ++_i) \
        __builtin_amdgcn_global_load_lds((const unsigned*)((const char*)(gbase) + (voff)[_i]), (PG8_LAS unsigned*)(lds + (bufoff) + ldsw + _i * 8192), 16, 0, 0); } while (0)
#define PG8_LDA(dst, b, h) do { _Pragma("unroll") for (int m = 0; m < 4; ++m) _Pragma("unroll") for (int k = 0; k < 2; ++k) dst[m][k] = *(const PG8_LAS bf16x8*)(lds + PG8_SA(b, h) + aoff + m * 2048 + k * 1024); } while (0)
#define PG8_LDB(dst, b, h) do { _Pragma("unroll") for (int n = 0; n < 2; ++n) _Pragma("unroll") for (int k = 0; k < 2; ++k) dst[n][k] = *(const PG8_LAS bf16x8*)(lds + PG8_SB(b, h) + boff + n * 2048 + k * 1024); } while (0)
#define PG8_MMA(ai, bj, At, Bt) do { __builtin_amdgcn_s_setprio(1); _Pragma("unroll") for (int m = 0; m < 4; ++m) _Pragma("unroll") for (int n = 0; n < 2; ++n) _Pragma("unroll") for (int k = 0; k < 2; ++k) \
        acc[ai][bj][m][n] = __builtin_amdgcn_mfma_f32_16x16x32_bf16(Bt[n][k], At[m][k], acc[ai][bj][m][n], 0, 0, 0); __builtin_amdgcn_s_setprio(0); } while (0)
#define PG8_WAIT_V(n) asm volatile("s_waitcnt vmcnt(" #n ")" ::: "memory")
#define PG8_WAIT_L(n) asm volatile("s_waitcnt lgkmcnt(" #n ")" ::: "memory")
#define PG8_BAR __builtin_amdgcn_s_barrier()
#define PG8_SCHED __builtin_amdgcn_sched_barrier(0)
    Unit cur, nxt; int ui = 0;
    if (!S.next(0, cur)) return;
    f32x4 acc[2][2][4][2];
#pragma unroll
    for (int a = 0; a < 2; ++a)
#pragma unroll
        for (int b = 0; b < 2; ++b)
#pragma unroll
            for (int m = 0; m < 4; ++m)
#pragma unroll
                for (int n = 0; n < 2; ++n) acc[a][b][m][n] = (f32x4){0.f, 0.f, 0.f, 0.f};
    bf16x8 At[4][2], B0[2][2], B1[2][2];
    const char* cA = (const char*)g.A + (size_t)cur.pm * tstep; const char* cB = (const char*)g.Bt + (size_t)cur.pn * tstep;
    S.a_ready(cur);
    if constexpr (SP2) {
        PG8_STAGE(PG8_SB(0, 0), cB, voffB); PG8_STAGE(PG8_SB(0, 1), cB + hstep, voffB); PG8_STAGE(PG8_SA(0, 0), cA, voffA); PG8_STAGE(PG8_SA(0, 1), cA + hstep, voffA);
        if (wr == 1) PG8_BAR;
        PG8_WAIT_V(2); PG8_BAR;
        PG8_STAGE(PG8_SB(1, 0), cB + kstep, voffB); PG8_STAGE(PG8_SA(1, 0), cA + kstep, voffA); PG8_STAGE(PG8_SB(1, 1), cB + hstep + kstep, voffB);
        PG8_WAIT_V(6); PG8_BAR;
    } else {
        PG8_STAGE(PG8_SB(0, 0), cB, voffB); PG8_STAGE(PG8_SA(0, 0), cA, voffA); PG8_STAGE(PG8_SB(0, 1), cB + hstep, voffB); PG8_STAGE(PG8_SA(0, 1), cA + hstep, voffA);
        if (wr == 1) PG8_BAR;
        PG8_WAIT_V(4); PG8_BAR;
        PG8_STAGE(PG8_SB(1, 0), cB + kstep, voffB); PG8_STAGE(PG8_SA(1, 0), cA + kstep, voffA); PG8_STAGE(PG8_SB(1, 1), cB + hstep + kstep, voffB);
        PG8_WAIT_V(6); PG8_BAR;
    }
    for (;;) {
        const bool has_next = S.next(ui + 1, nxt);
        const char* nA = has_next ? (const char*)g.A + (size_t)nxt.pm * tstep : cA; const char* nB = has_next ? (const char*)g.Bt + (size_t)nxt.pn * tstep : cB;
        for (int t = 0; t < nt; t += 2) {
            const bool last = (t == nt - 2);
            const char* a1 = cA + (size_t)(t + 1) * kstep;
            const char* a2 = last ? nA : cA + (size_t)(t + 2) * kstep; const char* b2 = last ? nB : cB + (size_t)(t + 2) * kstep;
            const char* a3 = a2 + kstep; const char* b3 = b2 + kstep;
            if (last && has_next) S.a_ready(nxt);
            if constexpr (SP2) {
            PG8_LDB(B0, 0, 0); PG8_LDB(B1, 0, 1); PG8_SCHED; PG8_LDA(At, 0, 0); PG8_STAGE(PG8_SA(1, 1), a1 + hstep, voffA);
            PG8_WAIT_V(8); PG8_WAIT_L(0); PG8_BAR; PG8_MMA(0, 0, At, B0); PG8_MMA(0, 1, At, B1); PG8_BAR; PG8_SCHED;
            PG8_LDA(At, 0, 1); PG8_STAGE(PG8_SB(0, 0), b2, voffB); PG8_STAGE(PG8_SB(0, 1), b2 + hstep, voffB); PG8_STAGE(PG8_SA(0, 0), a2, voffA);
            PG8_WAIT_V(8); PG8_WAIT_L(0); PG8_BAR; PG8_MMA(1, 0, At, B0); PG8_MMA(1, 1, At, B1); PG8_BAR; PG8_SCHED;
            PG8_LDB(B0, 1, 0); PG8_LDB(B1, 1, 1); PG8_SCHED; PG8_LDA(At, 1, 0); PG8_STAGE(PG8_SA(0, 1), a2 + hstep, voffA);
            PG8_WAIT_V(8); PG8_WAIT_L(0); PG8_BAR; PG8_MMA(0, 0, At, B0); PG8_MMA(0, 1, At, B1); PG8_BAR; PG8_SCHED;
            PG8_LDA(At, 1, 1); PG8_STAGE(PG8_SB(1, 0), b3, voffB); PG8_STAGE(PG8_SB(1, 1), b3 + hstep, voffB); PG8_STAGE(PG8_SA(1, 0), a3, voffA);
            PG8_WAIT_V(8); PG8_WAIT_L(0); PG8_BAR; PG8_MMA(1, 0, At, B0); PG8_MMA(1, 1, At, B1); PG8_BAR; PG8_SCHED;
            } else {
            PG8_LDB(B0, 0, 0); PG8_SCHED; PG8_LDA(At, 0, 0); PG8_STAGE(PG8_SA(1, 1), a1 + hstep, voffA);
            PG8_WAIT_L(8); PG8_BAR; PG8_WAIT_L(0); PG8_MMA(0, 0, At, B0); PG8_BAR; PG8_SCHED;
            PG8_LDB(B1, 0, 1); PG8_STAGE(PG8_SB(0, 0), b2, voffB);
            PG8_BAR; PG8_WAIT_L(0); PG8_MMA(0, 1, At, B1); PG8_BAR;
            PG8_LDA(At, 0, 1); PG8_STAGE(PG8_SA(0, 0), a2, voffA);
            PG8_BAR; PG8_WAIT_L(0); PG8_MMA(1, 0, At, B0); PG8_BAR; PG8_SCHED;
            PG8_STAGE(PG8_SB(0, 1), b2 + hstep, voffB);
            PG8_WAIT_V(6); PG8_BAR; PG8_MMA(1, 1, At, B1); PG8_BAR;
            PG8_LDB(B0, 1, 0); PG8_SCHED; PG8_LDA(At, 1, 0); PG8_STAGE(PG8_SA(0, 1), a2 + hstep, voffA);
            PG8_WAIT_L(8); PG8_BAR; PG8_WAIT_L(0); PG8_MMA(0, 0, At, B0); PG8_BAR; PG8_SCHED;
            PG8_LDB(B1, 1, 1); PG8_STAGE(PG8_SB(1, 0), b3, voffB);
            PG8_BAR; PG8_WAIT_L(0); PG8_MMA(0, 1, At, B1); PG8_BAR;
            PG8_LDA(At, 1, 1); PG8_STAGE(PG8_SA(1, 0), a3, voffA);
            PG8_BAR; PG8_WAIT_L(0); PG8_MMA(1, 0, At, B0); PG8_BAR; PG8_SCHED;
            PG8_STAGE(PG8_SB(1, 1), b3 + hstep, voffB);
            PG8_WAIT_V(6); PG8_BAR; PG8_MMA(1, 1, At, B1); PG8_BAR;
            }
        }
        if constexpr (ALIGN_EPI) { if (wr == 0) PG8_BAR; }
        if constexpr (!Epi::AFTER_DRAIN) { E(acc, cur, ui, wr, wc, fr, fq); S.done(cur); }
        if (!has_next) break;
        if (!E.keep(cur))
#pragma unroll
        for (int a = 0; a < 2; ++a)
#pragma unroll
            for (int b = 0; b < 2; ++b)
#pragma unroll
                for (int m = 0; m < 4; ++m)
#pragma unroll
                    for (int n = 0; n < 2; ++n) acc[a][b][m][n] = (f32x4){0.f, 0.f, 0.f, 0.f};
        cur = nxt; cA = nA; cB = nB; ++ui;
        if constexpr (ALIGN_EPI) { if (wr == 1) PG8_BAR; }
    }
    PG8_WAIT_V(0);
    if constexpr (!ALIGN_EPI) { if (wr == 0) PG8_BAR; }
    PG8_BAR;
    if constexpr (Epi::AFTER_DRAIN) { E.fused(acc, cur, wr, wc, fr, fq, lds, wid, lane); S.done(cur); }
#undef PG8_SA
#undef PG8_SB
#undef PG8_STAGE
#undef PG8_LDA
#undef PG8_LDB
#undef PG8_MMA
#undef PG8_WAIT_V
#undef PG8_WAIT_L
#undef PG8_BAR
#undef PG8_SCHED
}
}

using namespace pg8;
#define LAS __attribute__((address_space(3)))
typedef unsigned u32x2 __attribute__((ext_vector_type(2)));

constexpr int T_TOK = 16384, PROJ = 8720, NP = 8704, NPT = 8960;
constexpr size_t MiB = 1ull << 20;
constexpr size_t OFF_Q = 0, OFF_Z = 32 * MiB, OFF_OG = 64 * MiB, OFF_GA = 96 * MiB, OFF_GM = 128 * MiB, OFF_MV = 160 * MiB,
                 OFF_MQ = 192 * MiB, OFF_MK = 208 * MiB, OFF_K = 224 * MiB, OFF_V = 232 * MiB, OFF_WAT = 240 * MiB,
                 OFF_WOT = 244 * MiB, OFF_IF = 246 * MiB, OFF_BIASP = 247 * MiB, OFF_MLOC = OFF_BIASP + 65536,
                 OFF_GSUM = OFF_MLOC + 8192, OFF_MPREV = OFF_GSUM + 8192, OFF_BAR = OFF_MPREV + 8192, OFF_PCNT = OFF_BAR + 16384, OFF_ROWSS = OFF_PCNT + 16384, WS_END = OFF_ROWSS + 65536;
constexpr size_t OUT_H = 0, OUT_WTIN = 32 * MiB, OUT_CST = 0;
constexpr int BIAS_UNITS = 12;
constexpr int LDS_BYTES = 131072 + 16 + BIAS_UNITS * 1024;
constexpr int HSZ = 49408;

struct Params {
    const float *x, *norm_w, *w_in, *b_in, *sinks, *conv_w, *conv_b, *mnorm_w, *w_ba, *w_bm, *w_out, *fnorm_w;
    float* out; unsigned char* ws;
    int ph_lo, ph_hi;
};

__device__ __forceinline__ float bf_lo(unsigned w) { return __uint_as_float(w << 16); }
__device__ __forceinline__ float bf_hi(unsigned w) { return __uint_as_float(w & 0xffff0000u); }
__device__ __forceinline__ float bf2f(bf16_t b) { return __uint_as_float(((unsigned)b) << 16); }
__device__ __forceinline__ bf16_t f2bf(float f) { unsigned u = __float_as_uint(f); u += 0x7fffu + ((u >> 16) & 1u); return (bf16_t)(u >> 16); }
__device__ __forceinline__ float sigm(float x) { return __builtin_amdgcn_rcpf(1.f + __builtin_amdgcn_exp2f(-1.44269504f * x)); }
__device__ __forceinline__ float silu(float x) { return x * __builtin_amdgcn_rcpf(1.f + __builtin_amdgcn_exp2f(-1.44269504f * x)); }
__device__ __forceinline__ float wave_sum(float v) {
#pragma unroll
    for (int o = 1; o < 64; o <<= 1) v += __shfl_xor(v, o);
    return v;
}
__device__ __forceinline__ float wave_max(float v) {
#pragma unroll
    for (int o = 1; o < 64; o <<= 1) v = fmaxf(v, __shfl_xor(v, o));
    return v;
}
__device__ __forceinline__ f32x4 mfma16(bf16x8 a, bf16x8 b, f32x4 c) { return __builtin_amdgcn_mfma_f32_16x16x32_bf16(a, b, c, 0, 0, 0); }

__device__ __forceinline__ int src_col(int np) {
    if (np < 4608) return np;
    if (np < 6656) { const int t = (np - 4608) >> 8, r = np & 255; return (r < 128) ? (4624 + 128 * t + r) : (5648 + 128 * t + (r - 128)); }
    if (np >= 8704) return 4608 + (np - 8704);
    { const int t = (np - 6656) >> 8, r = np & 255; return (r < 128) ? (6672 + 128 * t + r) : (7696 + 128 * t + (r - 128)); }
}

__device__ __forceinline__ void transpose_item(const float* W, int N, int n_src0, bf16_t* WT, int row0, int k0, LAS float* scr, int lane) {
    f32x4 tv[8]; const int kr = lane >> 3, nc = (lane & 7) * 4;
#pragma unroll
    for (int i = 0; i < 8; ++i) tv[i] = *(const f32x4*)(W + (size_t)(k0 + kr + 8 * i) * N + n_src0 + nc);
#pragma unroll
    for (int i = 0; i < 8; ++i) { LAS float* d = scr + (kr + 8 * i) * 33 + nc; d[0] = tv[i].x; d[1] = tv[i].y; d[2] = tv[i].z; d[3] = tv[i].w; }
    asm volatile("s_waitcnt lgkmcnt(0)" ::: "memory");
    const int c = lane & 7;
#pragma unroll
    for (int j = 0; j < 4; ++j) { const int n = (lane >> 3) + 8 * j; const LAS float* s = scr + (8 * c) * 33 + n;
        u32x4 o; o.x = cvt_pk_bf16(s[0], s[33]); o.y = cvt_pk_bf16(s[66], s[99]); o.z = cvt_pk_bf16(s[132], s[165]); o.w = cvt_pk_bf16(s[198], s[231]);
        *(u32x4*)(WT + (size_t)(row0 + n) * 1024 + k0 + 8 * c) = o; }
    asm volatile("s_waitcnt lgkmcnt(0)" ::: "memory");
}

__device__ __forceinline__ void phase0(const Params& p, LAS unsigned char* lds, int G) {
    const int tid = threadIdx.x, lane = tid & 63, wave = tid >> 6;
    const int gw = blockIdx.x * 8 + wave, NGW = G * 8;
    bf16_t* WtIn = (bf16_t*)((unsigned char*)p.out + OUT_WTIN);
    bf16_t* WaT = (bf16_t*)(p.ws + OFF_WAT);
    bf16_t* WoT = (bf16_t*)(p.ws + OFF_WOT);
    LAS float* scr = (LAS float*)lds + wave * (64 * 33);
    constexpr int NBLK = NP / 32 + 1, I_IN = 16 * NBLK, I_SQ = 16 * 32;
    for (int it = gw; it < I_IN + 3 * I_SQ; it += NGW) {
        if (it < I_IN) { const int kb = it / NBLK, nb = it % NBLK; transpose_item(p.w_in, PROJ, src_col(nb * 32), WtIn, nb * 32, kb * 64, scr, lane); }
        else { int r = it - I_IN; const int mtx = r / I_SQ; r %= I_SQ; const int kb = r / 32, nb = r % 32;
            const float* W = mtx == 0 ? p.w_ba : (mtx == 1 ? p.w_bm : p.w_out);
            bf16_t* WT = mtx == 2 ? WoT : WaT; const int row0 = (mtx == 1 ? 1024 : 0) + nb * 32;
            transpose_item(W, 1024, nb * 32, WT, row0, kb * 64, scr, lane); }
    }
    float* biasp = (float*)(p.ws + OFF_BIASP);
    for (int i = blockIdx.x * 512 + tid; i < NP + 32; i += G * 512) biasp[i] = p.b_in[src_col(i)];
    bf16_t* H = (bf16_t*)((unsigned char*)p.out + OUT_H);
    f32x4 nwv[4], nxt[4];
#pragma unroll
    for (int j = 0; j < 4; ++j) { nwv[j] = ((const f32x4*)p.norm_w)[64 * j + lane]; nxt[j] = ((const f32x4*)(p.x + (size_t)gw * 1024) + lane)[64 * j]; }
    for (int row = gw; row < T_TOK; row += NGW) {
        f32x4 v[4]; float ss = 0.f;
#pragma unroll
        for (int j = 0; j < 4; ++j) v[j] = nxt[j];
        if (row + NGW < T_TOK) {
#pragma unroll
            for (int j = 0; j < 4; ++j) nxt[j] = ((const f32x4*)(p.x + (size_t)(row + NGW) * 1024) + lane)[64 * j]; }
#pragma unroll
        for (int j = 0; j < 4; ++j) ss += (v[j].x * v[j].x + v[j].y * v[j].y) + (v[j].z * v[j].z + v[j].w * v[j].w);
        ss = wave_sum(ss);
        const float rstd = rsqrtf(ss * (1.f / 1024.f) + 1e-6f);
#pragma unroll
        for (int j = 0; j < 4; ++j) { const f32x4 nw = nwv[j]; v[j] = v[j] * rstd * nw;
            u32x2 o; o.x = cvt_pk_bf16(v[j].x, v[j].y); o.y = cvt_pk_bf16(v[j].z, v[j].w);
            *((u32x2*)(H + (size_t)row * 1024) + 64 * j + lane) = o; }
    }
}

struct Epi1 {
    static constexpr bool PERM = true, AFTER_DRAIN = false;
    unsigned char* ws; const LAS float* biasl;
    __device__ __forceinline__ bool keep(const Unit&) const { return false; }
    __device__ __forceinline__ void operator()(const f32x4 (&acc)[2][2][4][2], const Unit& u, int ui, int wr, int wc, int fr, int fq) const {
        const int pn = u.pn, row0 = u.pm * BM + wr * 64 + fr, lc = wc * 32 + 8 * fq;
        f32x4 bv[2][2];
#pragma unroll
        for (int bj = 0; bj < 2; ++bj)
#pragma unroll
            for (int n = 0; n < 2; ++n) bv[bj][n] = *(const LAS f32x4*)(biasl + ui * 256 + bj * HALF + lc + 4 * n);
        if (pn == 34) {
            if (wc == 0 && fq < 2) { float* IF = (float*)(ws + OFF_IF);
#pragma unroll
                for (int ai = 0; ai < 2; ++ai)
#pragma unroll
                    for (int m = 0; m < 4; ++m) { float* gp = IF + (size_t)(row0 + ai * HALF + m * 16) * 16 + 8 * fq;
                        *(f32x4*)gp = acc[ai][0][m][0] + bv[0][0]; *(f32x4*)(gp + 4) = acc[ai][0][m][1] + bv[0][1]; } }
            return;
        }
        if (pn >= 26) {
            bf16_t* RA = (bf16_t*)(ws + OFF_GA); bf16_t* GMb = (bf16_t*)(ws + OFF_GM); const int cb = (pn - 26) * 128 + lc;
#pragma unroll
            for (int ai = 0; ai < 2; ++ai)
#pragma unroll
                for (int m = 0; m < 4; ++m) { float ra[8], gm[8];
#pragma unroll
                    for (int n = 0; n < 2; ++n)
#pragma unroll
                        for (int i = 0; i < 4; ++i) { const float a = acc[ai][0][m][n][i] + bv[0][n][i], b = acc[ai][1][m][n][i] + bv[1][n][i];
                            const float da = 1.f + __builtin_amdgcn_exp2f(-1.44269504f * a), db = 1.f + __builtin_amdgcn_exp2f(-1.44269504f * b);
                            ra[4 * n + i] = db * __builtin_amdgcn_rcpf(da); gm[4 * n + i] = __builtin_amdgcn_rcpf(db); }
                    u32x4 w; w.x = cvt_pk_bf16(ra[0], ra[1]); w.y = cvt_pk_bf16(ra[2], ra[3]); w.z = cvt_pk_bf16(ra[4], ra[5]); w.w = cvt_pk_bf16(ra[6], ra[7]);
                    const size_t o = (size_t)(row0 + ai * HALF + m * 16) * 1024 + cb;
                    *(u32x4*)(RA + o) = w;
                    w.x = cvt_pk_bf16(gm[0], gm[1]); w.y = cvt_pk_bf16(gm[2], gm[3]); w.z = cvt_pk_bf16(gm[4], gm[5]); w.w = cvt_pk_bf16(gm[6], gm[7]);
                    *(u32x4*)(GMb + o) = w; }
            return;
        }
        if (pn >= 18 && pn < 26) {
            bf16_t* OG = (bf16_t*)(ws + OFF_OG); const int cb = (pn - 18) * 128 + lc;
#pragma unroll
            for (int ai = 0; ai < 2; ++ai)
#pragma unroll
                for (int m = 0; m < 4; ++m) { float r[8];
#pragma unroll
                    for (int n = 0; n < 2; ++n)
#pragma unroll
                        for (int i = 0; i < 4; ++i) { const float o = acc[ai][0][m][n][i] + bv[0][n][i], z = acc[ai][1][m][n][i] + bv[1][n][i]; r[4 * n + i] = sigm(o) * silu(z); }
                    u32x4 w; w.x = cvt_pk_bf16(r[0], r[1]); w.y = cvt_pk_bf16(r[2], r[3]); w.z = cvt_pk_bf16(r[4], r[5]); w.w = cvt_pk_bf16(r[6], r[7]);
                    *(u32x4*)(OG + (size_t)(row0 + ai * HALF + m * 16) * 1024 + cb) = w; }
            return;
        }
        size_t off; int ld, c0, act;
        if (pn < 4) { off = OFF_Q; ld = 1024; c0 = pn * 256; act = 1; }
        else if (pn == 4) { off = OFF_K; ld = 256; c0 = 0; act = 0; }
        else if (pn == 5) { off = OFF_V; ld = 256; c0 = 0; act = 0; }
        else if (pn < 10) { off = OFF_Z; ld = 1024; c0 = (pn - 6) * 256; act = 2; }
        else if (pn < 12) { off = OFF_MQ; ld = 512; c0 = (pn - 10) * 256; act = 0; }
        else if (pn < 14) { off = OFF_MK; ld = 512; c0 = (pn - 12) * 256; act = 0; }
        else { off = OFF_MV; ld = 1024; c0 = (pn - 14) * 256; act = 0; }
        bf16_t* dst = (bf16_t*)(ws + off) + c0 + lc;
#pragma unroll
        for (int ai = 0; ai < 2; ++ai)
#pragma unroll
            for (int m = 0; m < 4; ++m) { bf16_t* rowp = dst + (size_t)(row0 + ai * HALF + m * 16) * ld;
#pragma unroll
                for (int bj = 0; bj < 2; ++bj) { f32x4 v0 = acc[ai][bj][m][0] + bv[bj][0], v1 = acc[ai][bj][m][1] + bv[bj][1];
                    if (act == 1) { v0 = v0 * 0.18033688f; v1 = v1 * 0.18033688f; }
                    else if (act == 2) {
#pragma unroll
                        for (int i = 0; i < 4; ++i) { v0[i] = silu(v0[i]); v1[i] = silu(v1[i]); } }
                    else if (act == 3) {
#pragma unroll
                        for (int i = 0; i < 4; ++i) { v0[i] = sigm(v0[i]); v1[i] = sigm(v1[i]); } }
                    u32x4 w; w.x = cvt_pk_bf16(v0[0], v0[1]); w.y = cvt_pk_bf16(v0[2], v0[3]); w.z = cvt_pk_bf16(v1[0], v1[1]); w.w = cvt_pk_bf16(v1[2], v1[3]);
                    *(u32x4*)(rowp + bj * HALF) = w; } }
    }
};

__device__ __forceinline__ void attn_item(const Params& p, LAS unsigned char* lds, int it) {
    const int tid = threadIdx.x, lane = tid & 63, wave = tid >> 6, fr = lane & 15, fq = lane >> 4;
    const int b = it >> 7, kvh = (it >> 5) & 3, qb = it & 31, t0 = b * 4096 + qb * 128;
    LAS bf16_t* Ks = (LAS bf16_t*)lds;
    LAS bf16_t* Vs = Ks + 256 * 72;
    const bf16_t* Kb = (const bf16_t*)(p.ws + OFF_K); const bf16_t* Vb = (const bf16_t*)(p.ws + OFF_V);
    const bf16_t* Q = (const bf16_t*)(p.ws + OFF_Q); bf16_t* Z = (bf16_t*)(p.ws + OFF_Z);
    const unsigned vtr_base = (unsigned)(size_t)Vs + (unsigned)((4 * fq + ((lane & 15) >> 2)) * 144 + (lane & 3) * 8);
    const int g = wave & 3, half = wave >> 2, hq = kvh * 4 + g; const float sink = p.sinks[hq] * 1.44269504f; const int dlt = fq * 4 - fr;
    u32x4 kraw[4], vraw[4];
#pragma unroll
    for (int i = 0; i < 4; ++i) { const int c = tid + 512 * i, sj = c >> 3, dc = c & 7; kraw[i] = (u32x4){0u, 0u, 0u, 0u}; vraw[i] = (u32x4){0u, 0u, 0u, 0u};
        if (qb > 0 || sj >= 128) { const size_t off = (size_t)(t0 - 128 + sj) * 256 + kvh * 64 + dc * 8; kraw[i] = *(const u32x4*)(Kb + off); vraw[i] = *(const u32x4*)(Vb + off); } }
    bf16x8 qf[2][2][2]; u32x2 zz[2][2][4];
#pragma unroll
    for (int qc = 0; qc < 2; ++qc)
#pragma unroll
        for (int qs = 0; qs < 2; ++qs) { const size_t ro = (size_t)(t0 + half * 64 + qc * 32 + qs * 16 + fr) * 1024 + hq * 64;
#pragma unroll
            for (int ks = 0; ks < 2; ++ks) qf[qc][qs][ks] = *(const bf16x8*)(Q + ro + ks * 32 + fq * 8);
#pragma unroll
            for (int dt = 0; dt < 4; ++dt) zz[qc][qs][dt] = *(const u32x2*)(Z + ro + dt * 16 + fq * 4); }
#pragma unroll
    for (int i = 0; i < 4; ++i) { const int c = tid + 512 * i, sj = c >> 3, dc = c & 7;
        *(LAS u32x4*)(Ks + sj * 72 + dc * 8) = kraw[i]; *(LAS u32x4*)(Vs + sj * 72 + dc * 8) = vraw[i]; }
    __syncthreads();
#pragma unroll
    for (int qc = 0; qc < 2; ++qc) {
        const int i0 = half * 64 + qc * 32;
        f32x4 s[10][2];
#pragma unroll
        for (int kt = 0; kt < 10; ++kt) { s[kt][0] = (f32x4){0.f, 0.f, 0.f, 0.f}; s[kt][1] = (f32x4){0.f, 0.f, 0.f, 0.f};
#pragma unroll
            for (int ks = 0; ks < 2; ++ks) { const bf16x8 kf = *(const LAS bf16x8*)(Ks + (i0 + kt * 16 + fr) * 72 + ks * 32 + fq * 8);
                s[kt][0] = mfma16(kf, qf[qc][0][ks], s[kt][0]); s[kt][1] = mfma16(kf, qf[qc][1][ks], s[kt][1]); } }
        float mx[2] = {sink, sink};
        const int lowtile = (qb == 0) ? ((128 - i0) >> 4) : 0;
#pragma unroll
        for (int kt = 0; kt < 10; ++kt) {
            if (kt < lowtile) { s[kt][0] = (f32x4){-INFINITY, -INFINITY, -INFINITY, -INFINITY}; s[kt][1] = s[kt][0]; }
#pragma unroll
            for (int qs = 0; qs < 2; ++qs)
#pragma unroll
                for (int r = 0; r < 4; ++r) { float sv = s[kt][qs][r];
                    if (kt - qs <= 0) sv = ((kt - qs) * 16 + r + dlt > 0) ? sv : -INFINITY;
                    if (kt - qs >= 8) sv = ((kt - qs) * 16 + r + dlt <= 128) ? sv : -INFINITY;
                    s[kt][qs][r] = sv; mx[qs] = fmaxf(mx[qs], sv); } }
        float inv[2];
#pragma unroll
        for (int qs = 0; qs < 2; ++qs) { mx[qs] = fmaxf(mx[qs], __shfl_xor(mx[qs], 16)); mx[qs] = fmaxf(mx[qs], __shfl_xor(mx[qs], 32)); }
        float sum[2] = {0.f, 0.f};
#pragma unroll
        for (int kt = 0; kt < 10; ++kt)
#pragma unroll
            for (int qs = 0; qs < 2; ++qs)
#pragma unroll
                for (int r = 0; r < 4; ++r) { const float pv = __builtin_amdgcn_exp2f(s[kt][qs][r] - mx[qs]); s[kt][qs][r] = pv; sum[qs] += pv; }
#pragma unroll
        for (int qs = 0; qs < 2; ++qs) { sum[qs] += __shfl_xor(sum[qs], 16); sum[qs] += __shfl_xor(sum[qs], 32); inv[qs] = __builtin_amdgcn_rcpf(sum[qs] + __builtin_amdgcn_exp2f(sink - mx[qs])); }
        f32x4 o[4][2];
#pragma unroll
        for (int dt = 0; dt < 4; ++dt) { o[dt][0] = (f32x4){0.f, 0.f, 0.f, 0.f}; o[dt][1] = (f32x4){0.f, 0.f, 0.f, 0.f}; }
#pragma unroll
        for (int kp = 0; kp < 5; ++kp) {
            bf16x8 pf[2];
#pragma unroll
            for (int qs = 0; qs < 2; ++qs) { u32x4 w; w.x = cvt_pk_bf16(s[2 * kp][qs][0], s[2 * kp][qs][1]); w.y = cvt_pk_bf16(s[2 * kp][qs][2], s[2 * kp][qs][3]);
                w.z = cvt_pk_bf16(s[2 * kp + 1][qs][0], s[2 * kp + 1][qs][1]); w.w = cvt_pk_bf16(s[2 * kp + 1][qs][2], s[2 * kp + 1][qs][3]); pf[qs] = __builtin_bit_cast(bf16x8, w); }
            u32x2 t0r[4], t1r[4];
            { const unsigned a = vtr_base + (unsigned)((i0 + kp * 32) * 144);
              asm volatile("ds_read_b64_tr_b16 %0, %8\n\tds_read_b64_tr_b16 %1, %8 offset:2304\n\tds_read_b64_tr_b16 %2, %8 offset:32\n\tds_read_b64_tr_b16 %3, %8 offset:2336\n\t"
                           "ds_read_b64_tr_b16 %4, %8 offset:64\n\tds_read_b64_tr_b16 %5, %8 offset:2368\n\tds_read_b64_tr_b16 %6, %8 offset:96\n\tds_read_b64_tr_b16 %7, %8 offset:2400\n\ts_waitcnt lgkmcnt(0)"
                           : "=&v"(t0r[0]), "=&v"(t1r[0]), "=&v"(t0r[1]), "=&v"(t1r[1]), "=&v"(t0r[2]), "=&v"(t1r[2]), "=&v"(t0r[3]), "=&v"(t1r[3]) : "v"(a) : "memory"); }
#pragma unroll
            for (int dt = 0; dt < 4; ++dt) { u32x4 aw; aw.x = t0r[dt].x; aw.y = t0r[dt].y; aw.z = t1r[dt].x; aw.w = t1r[dt].y; const bf16x8 vf = __builtin_bit_cast(bf16x8, aw);
                o[dt][0] = mfma16(vf, pf[0], o[dt][0]); o[dt][1] = mfma16(vf, pf[1], o[dt][1]); } }
#pragma unroll
        for (int qs = 0; qs < 2; ++qs)
#pragma unroll
            for (int dt = 0; dt < 4; ++dt) { bf16_t* zp = Z + (size_t)(t0 + i0 + qs * 16 + fr) * 1024 + hq * 64 + dt * 16 + fq * 4;
                const u32x2 z2 = zz[qc][qs][dt]; u32x2 w;
                w.x = cvt_pk_bf16(o[dt][qs][0] * inv[qs] * bf_lo(z2.x), o[dt][qs][1] * inv[qs] * bf_hi(z2.x));
                w.y = cvt_pk_bf16(o[dt][qs][2] * inv[qs] * bf_lo(z2.y), o[dt][qs][3] * inv[qs] * bf_hi(z2.y));
                *(u32x2*)zp = w; }
    }
    __syncthreads();
}

__device__ __forceinline__ void gates_from(float f, int lane, float& bcum) {
    float lf = fminf(f, 0.f) - log1pf(expf(-fabsf(f)));
#pragma unroll
    for (int o = 1; o < 64; o <<= 1) { const float t = __shfl_up(lf, o); if (lane >= o) lf += t; }
    bcum = lf;
}
__device__ __forceinline__ void conv_load(const bf16_t* U, int t, int pos, int bcol, u32x4 (&r)[4]) {
#pragma unroll
    for (int j = 0; j < 4; ++j) { r[j] = (u32x4){0u, 0u, 0u, 0u}; if (pos - 3 + j >= 0) r[j] = *(const u32x4*)(U + (size_t)(t - 3 + j) * 512 + bcol); }
}
__device__ __forceinline__ void conv_compute(const Params& p, const u32x4 (&r)[4], int cch, float (&o)[8]) {
    const f32x4* cb = (const f32x4*)(p.conv_b + cch); const f32x4 b0 = cb[0], b1 = cb[1];
    o[0] = b0.x; o[1] = b0.y; o[2] = b0.z; o[3] = b0.w; o[4] = b1.x; o[5] = b1.y; o[6] = b1.z; o[7] = b1.w;
#pragma unroll
    for (int j = 0; j < 4; ++j) { const u32x4 w = r[j];
        const f32x4* cw = (const f32x4*)(p.conv_w + j * 1024 + cch); const f32x4 w0 = cw[0], w1 = cw[1];
        o[0] += w0.x * bf_lo(w.x); o[1] += w0.y * bf_hi(w.x); o[2] += w0.z * bf_lo(w.y); o[3] += w0.w * bf_hi(w.y);
        o[4] += w1.x * bf_lo(w.z); o[5] += w1.y * bf_hi(w.z); o[6] += w1.z * bf_lo(w.w); o[7] += w1.w * bf_hi(w.w); }
}
__device__ __forceinline__ void vn_load(const Params& p, int ts, int hh, int hl, u32x4 (&vraw)[4]) {
    const bf16_t* MV = (const bf16_t*)(p.ws + OFF_MV);
#pragma unroll
    for (int i = 0; i < 4; ++i) { const int task = hl + 256 * i, vg = task & 15, l = task >> 4; vraw[i] = *(const u32x4*)(MV + (size_t)(ts + l) * 1024 + hh * 128 + vg * 8); }
}
__device__ __forceinline__ void vn_store(LAS bf16_t* Vn, int hl, const u32x4 (&vraw)[4]) {
#pragma unroll
    for (int i = 0; i < 4; ++i) { const int task = hl + 256 * i, vg = task & 15, l = task >> 4; *(LAS u32x4*)(Vn + l * 152 + vg * 8) = vraw[i]; }
    if (hl < 128) { const int l = hl >> 1, h2 = hl & 1; *(LAS u32x4*)(Vn + l * 152 + 128 + h2 * 8) = (u32x4){h2 ? 0u : 0x3F80u, 0u, 0u, 0u}; }
}

__device__ __forceinline__ void mlstm_pass1(const Params& p, LAS unsigned char* lds, int itp) {
    const int tid = threadIdx.x, lane = tid & 63, wave = __builtin_amdgcn_readfirstlane(tid >> 6), fr = lane & 15, fq = lane >> 4;
    const int sub = wave >> 2, hw = wave & 3, hl = tid & 255;
    const int item = 2 * itp + sub, b = item >> 9, hh = (item >> 6) & 7, c = item & 63, ts = b * 4096 + c * 64;
    LAS unsigned char* base = lds + sub * HSZ;
    LAS float* wts = (LAS float*)base;
    LAS bf16_t* Kw = (LAS bf16_t*)(base + 2048);
    LAS bf16_t* Vn = Kw + 64 * 72;
    const float* IF = (const float*)(p.ws + OFF_IF);
    const bf16_t* MK = (const bf16_t*)(p.ws + OFF_MK);
    float gf = 0.f, gi = 0.f;
    if (hw == 0) { gf = IF[(size_t)(ts + lane) * 16 + 8 + hh]; gi = IF[(size_t)(ts + lane) * 16 + hh]; }
    u32x4 kraw[2][4], vraw[4];
#pragma unroll
    for (int i = 0; i < 2; ++i) { const int task = hl + 256 * i, kg = task & 7, l = task >> 3; conv_load(MK, ts + l, c * 64 + l, hh * 64 + kg * 8, kraw[i]); }
    vn_load(p, ts, hh, hl, vraw);
    if (hw == 0) { float bc; gates_from(gf, lane, bc);
        const float gs = __shfl(bc, 63), a = gs - bc + gi, ml = wave_max(a);
        wts[lane] = expf(a - ml);
        if (lane == 0) { ((float*)(p.ws + OFF_MLOC))[item] = ml; ((float*)(p.ws + OFF_GSUM))[item] = gs; } }
    __syncthreads();
#pragma unroll
    for (int i = 0; i < 2; ++i) { const int task = hl + 256 * i, kg = task & 7, l = task >> 3; float kc[8]; conv_compute(p, kraw[i], 512 + hh * 64 + kg * 8, kc);
        const float w = wts[l]; u32x4 wk;
        wk.x = cvt_pk_bf16(silu(kc[0]) * w, silu(kc[1]) * w); wk.y = cvt_pk_bf16(silu(kc[2]) * w, silu(kc[3]) * w);
        wk.z = cvt_pk_bf16(silu(kc[4]) * w, silu(kc[5]) * w); wk.w = cvt_pk_bf16(silu(kc[6]) * w, silu(kc[7]) * w);
        *(LAS u32x4*)(Kw + l * 72 + kg * 8) = wk; }
    vn_store(Vn, hl, vraw);
    __syncthreads();
    f32x4 acc[9];
#pragma unroll
    for (int vt = 0; vt < 9; ++vt) acc[vt] = (f32x4){0.f, 0.f, 0.f, 0.f};
    const unsigned vtr1 = (unsigned)(size_t)Vn + (unsigned)((8 * fq + ((lane & 15) >> 2)) * 304 + (lane & 3) * 8);
    const unsigned ktr1 = (unsigned)(size_t)Kw + (unsigned)((8 * fq + ((lane & 15) >> 2)) * 144 + (lane & 3) * 8 + hw * 32);
#pragma unroll
    for (int ks = 0; ks < 2; ++ks) { u32x2 kt0, kt1;
        { const unsigned a = ktr1 + (unsigned)(ks * 4608);
          asm volatile("ds_read_b64_tr_b16 %0, %2\n\tds_read_b64_tr_b16 %1, %2 offset:576\n\ts_waitcnt lgkmcnt(0)" : "=&v"(kt0), "=&v"(kt1) : "v"(a) : "memory"); }
        u32x4 bw; bw.x = kt0.x; bw.y = kt0.y; bw.z = kt1.x; bw.w = kt1.y; const bf16x8 bf = __builtin_bit_cast(bf16x8, bw);
        u32x2 tr[9][2];
        { const unsigned a = vtr1 + (unsigned)(ks * 9728);
          asm volatile("ds_read_b64_tr_b16 %0, %18\n\tds_read_b64_tr_b16 %1, %18 offset:1216\n\tds_read_b64_tr_b16 %2, %18 offset:32\n\tds_read_b64_tr_b16 %3, %18 offset:1248\n\tds_read_b64_tr_b16 %4, %18 offset:64\n\tds_read_b64_tr_b16 %5, %18 offset:1280\n\tds_read_b64_tr_b16 %6, %18 offset:96\n\tds_read_b64_tr_b16 %7, %18 offset:1312\n\tds_read_b64_tr_b16 %8, %18 offset:128\n\tds_read_b64_tr_b16 %9, %18 offset:1344\n\tds_read_b64_tr_b16 %10, %18 offset:160\n\tds_read_b64_tr_b16 %11, %18 offset:1376\n\tds_read_b64_tr_b16 %12, %18 offset:192\n\tds_read_b64_tr_b16 %13, %18 offset:1408\n\tds_read_b64_tr_b16 %14, %18 offset:224\n\tds_read_b64_tr_b16 %15, %18 offset:1440\n\tds_read_b64_tr_b16 %16, %18 offset:256\n\tds_read_b64_tr_b16 %17, %18 offset:1472\n\ts_waitcnt lgkmcnt(0)" : "=&v"(tr[0][0]), "=&v"(tr[0][1]), "=&v"(tr[1][0]), "=&v"(tr[1][1]), "=&v"(tr[2][0]), "=&v"(tr[2][1]), "=&v"(tr[3][0]), "=&v"(tr[3][1]), "=&v"(tr[4][0]), "=&v"(tr[4][1]), "=&v"(tr[5][0]), "=&v"(tr[5][1]), "=&v"(tr[6][0]), "=&v"(tr[6][1]), "=&v"(tr[7][0]), "=&v"(tr[7][1]), "=&v"(tr[8][0]), "=&v"(tr[8][1]) : "v"(a) : "memory"); }
#pragma unroll
        for (int vt = 0; vt < 9; ++vt) { u32x4 aw; aw.x = tr[vt][0].x; aw.y = tr[vt][0].y; aw.z = tr[vt][1].x; aw.w = tr[vt][1].y; acc[vt] = mfma16(__builtin_bit_cast(bf16x8, aw), bf, acc[vt]); } }
    bf16_t* cst = (bf16_t*)((unsigned char*)p.out + OUT_CST) + (size_t)item * 9216;
#pragma unroll
    for (int vt = 0; vt < 9; ++vt)
#pragma unroll
        for (int r = 0; r < 4; ++r) cst[(vt * 16 + fq * 4 + r) * 64 + hw * 16 + fr] = f2bf(acc[vt][r]);
    __syncthreads();
}


__device__ __forceinline__ void mlstm_scan(const Params& p, int G) {
    const float* mloc = (const float*)(p.ws + OFF_MLOC); const float* gsum = (const float*)(p.ws + OFF_GSUM); float* mprev = (float*)(p.ws + OFF_MPREV);
    bf16_t* cst = (bf16_t*)((unsigned char*)p.out + OUT_CST);
    const int per = (32 * 2304 + G - 1) / G, t0 = blockIdx.x * per, t1 = (t0 + per < 32 * 2304) ? t0 + per : 32 * 2304;
    for (int task = t0 + threadIdx.x; task < t1; task += 512) {
        const int bh = task / 2304, e = task % 2304;
        float s0 = 0.f, s1 = 0.f, s2 = 0.f, s3 = 0.f, m = -1e30f;
        u32x2* ptr = (u32x2*)(cst + (size_t)bh * 64 * 9216 + e * 4);
        for (int c0 = 0; c0 < 64; c0 += 16) { u32x2 clv[16]; float glv[16], mlv[16];
#pragma unroll
            for (int i = 0; i < 16; ++i) { clv[i] = ptr[(size_t)i * (9216 / 4)]; glv[i] = gsum[bh * 64 + c0 + i]; mlv[i] = mloc[bh * 64 + c0 + i]; }
#pragma unroll
            for (int i = 0; i < 16; ++i) { const float gl = glv[i], ml = mlv[i]; const u32x2 cl = clv[i];
                u32x2 w; w.x = cvt_pk_bf16(s0, s1); w.y = cvt_pk_bf16(s2, s3); ptr[(size_t)i * (9216 / 4)] = w;
                if (e == 0) mprev[bh * 64 + c0 + i] = m;
                const float mn = fmaxf(gl + m, ml), sp = __expf(gl + m - mn), sl = __expf(ml - mn);
                s0 = sp * s0 + sl * bf_lo(cl.x); s1 = sp * s1 + sl * bf_hi(cl.x); s2 = sp * s2 + sl * bf_lo(cl.y); s3 = sp * s3 + sl * bf_hi(cl.y);
                m = mn; }
            ptr += 16 * (9216 / 4); }
    }
}

__device__ __forceinline__ void mlstm_pass3(const Params& p, LAS unsigned char* lds, int itp) {
    const int tid = threadIdx.x, lane = tid & 63, wave = __builtin_amdgcn_readfirstlane(tid >> 6), fr = lane & 15, fq = lane >> 4;
    const int sub = wave >> 2, hw = wave & 3, hl = tid & 255;
    const int item = 2 * itp + sub, b = item >> 9, hh = (item >> 6) & 7, c = item & 63, ts = b * 4096 + c * 64;
    LAS unsigned char* base = lds + sub * HSZ;
    LAS float* fb = (LAS float*)base; LAS float* fu = fb + 64; LAS float* fM = fb + 128; LAS float* fI = fb + 192;
    LAS bf16_t* Ks = (LAS bf16_t*)(base + 2048);
    LAS bf16_t* Vn = Ks + 64 * 72;
    LAS bf16_t* Qs = Vn + 64 * 152;
    const float* IF = (const float*)(p.ws + OFF_IF);
    const bf16_t* MQ = (const bf16_t*)(p.ws + OFF_MQ); const bf16_t* MK = (const bf16_t*)(p.ws + OFF_MK);
    bf16_t* OG = (bf16_t*)(p.ws + OFF_OG);
    const bf16_t* cst = (const bf16_t*)((unsigned char*)p.out + OUT_CST) + (size_t)item * 9216;
    float gf = 0.f, gi = 0.f, mp = 0.f;
    if (hw == 0) { gf = IF[(size_t)(ts + lane) * 16 + 8 + hh]; gi = IF[(size_t)(ts + lane) * 16 + hh]; mp = ((const float*)(p.ws + OFF_MPREV))[item]; }
    u32x4 qraw[2][4], kraw[2][4], vraw[4];
#pragma unroll
    for (int i = 0; i < 2; ++i) { const int task = hl + 256 * i, kg = task & 7, l = task >> 3;
        conv_load(MQ, ts + l, c * 64 + l, hh * 64 + kg * 8, qraw[i]); conv_load(MK, ts + l, c * 64 + l, hh * 64 + kg * 8, kraw[i]); }
    vn_load(p, ts, hh, hl, vraw);
    if (hw == 0) { float bc; gates_from(gf, lane, bc);
        const float u = gi - bc; float pm = u;
#pragma unroll
        for (int o = 1; o < 64; o <<= 1) { const float t = __shfl_up(pm, o); if (lane >= o) pm = fmaxf(pm, t); }
        const float M = fmaxf(mp, pm);
        fb[lane] = bc; fu[lane] = u * 1.44269504f; fM[lane] = M; fI[lane] = expf(mp - M); }
#pragma unroll
    for (int i = 0; i < 2; ++i) { const int task = hl + 256 * i, kg = task & 7, l = task >> 3; float qc[8], kc[8];
        conv_compute(p, qraw[i], hh * 64 + kg * 8, qc); conv_compute(p, kraw[i], 512 + hh * 64 + kg * 8, kc);
        u32x4 wq, wk;
        wq.x = cvt_pk_bf16(0.125f * silu(qc[0]), 0.125f * silu(qc[1])); wq.y = cvt_pk_bf16(0.125f * silu(qc[2]), 0.125f * silu(qc[3]));
        wq.z = cvt_pk_bf16(0.125f * silu(qc[4]), 0.125f * silu(qc[5])); wq.w = cvt_pk_bf16(0.125f * silu(qc[6]), 0.125f * silu(qc[7]));
        wk.x = cvt_pk_bf16(silu(kc[0]), silu(kc[1])); wk.y = cvt_pk_bf16(silu(kc[2]), silu(kc[3]));
        wk.z = cvt_pk_bf16(silu(kc[4]), silu(kc[5])); wk.w = cvt_pk_bf16(silu(kc[6]), silu(kc[7]));
        *(LAS u32x4*)(Qs + l * 72 + kg * 8) = wq; *(LAS u32x4*)(Ks + l * 72 + kg * 8) = wk; }
    vn_store(Vn, hl, vraw);
    __syncthreads();
    const int l = hw * 16 + fr;
    const unsigned vtr3 = (unsigned)(size_t)Vn + (unsigned)((4 * fq + ((lane & 15) >> 2)) * 304 + (lane & 3) * 8);
    bf16x8 qf[2];
#pragma unroll
    for (int ks = 0; ks < 2; ++ks) qf[ks] = *(const LAS bf16x8*)(Qs + l * 72 + ks * 32 + fq * 8);
    f32x4 sT[4];
#pragma unroll
    for (int st = 0; st < 4; ++st) { sT[st] = (f32x4){0.f, 0.f, 0.f, 0.f};
#pragma unroll
        for (int ks = 0; ks < 2; ++ks) { const bf16x8 kf = *(const LAS bf16x8*)(Ks + (st * 16 + fr) * 72 + ks * 32 + fq * 8); sT[st] = mfma16(kf, qf[ks], sT[st]); } }
    const float Ml = fM[l], Ml2 = Ml * 1.44269504f;
#pragma unroll
    for (int st = 0; st < 4; ++st) { const f32x4 uv = *(const LAS f32x4*)(fu + st * 16 + fq * 4);
#pragma unroll
        for (int r = 0; r < 4; ++r) { const int s = st * 16 + fq * 4 + r; sT[st][r] = (s <= l) ? sT[st][r] * __builtin_amdgcn_exp2f(uv[r] - Ml2) : 0.f; } }
    f32x4 ai[9], ae[9];
#pragma unroll
    for (int vt = 0; vt < 9; ++vt) { ai[vt] = (f32x4){0.f, 0.f, 0.f, 0.f}; ae[vt] = (f32x4){0.f, 0.f, 0.f, 0.f}; }
#pragma unroll
    for (int kk = 0; kk < 2; ++kk) {
        u32x4 w; w.x = cvt_pk_bf16(sT[2 * kk][0], sT[2 * kk][1]); w.y = cvt_pk_bf16(sT[2 * kk][2], sT[2 * kk][3]);
        w.z = cvt_pk_bf16(sT[2 * kk + 1][0], sT[2 * kk + 1][1]); w.w = cvt_pk_bf16(sT[2 * kk + 1][2], sT[2 * kk + 1][3]);
        const bf16x8 pf = __builtin_bit_cast(bf16x8, w);
        u32x2 tr[9][2];
        { const unsigned a = vtr3 + (unsigned)(kk * 9728);
          asm volatile("ds_read_b64_tr_b16 %0, %18\n\tds_read_b64_tr_b16 %1, %18 offset:4864\n\tds_read_b64_tr_b16 %2, %18 offset:32\n\tds_read_b64_tr_b16 %3, %18 offset:4896\n\tds_read_b64_tr_b16 %4, %18 offset:64\n\tds_read_b64_tr_b16 %5, %18 offset:4928\n\tds_read_b64_tr_b16 %6, %18 offset:96\n\tds_read_b64_tr_b16 %7, %18 offset:4960\n\tds_read_b64_tr_b16 %8, %18 offset:128\n\tds_read_b64_tr_b16 %9, %18 offset:4992\n\tds_read_b64_tr_b16 %10, %18 offset:160\n\tds_read_b64_tr_b16 %11, %18 offset:5024\n\tds_read_b64_tr_b16 %12, %18 offset:192\n\tds_read_b64_tr_b16 %13, %18 offset:5056\n\tds_read_b64_tr_b16 %14, %18 offset:224\n\tds_read_b64_tr_b16 %15, %18 offset:5088\n\tds_read_b64_tr_b16 %16, %18 offset:256\n\tds_read_b64_tr_b16 %17, %18 offset:5120\n\ts_waitcnt lgkmcnt(0)" : "=&v"(tr[0][0]), "=&v"(tr[0][1]), "=&v"(tr[1][0]), "=&v"(tr[1][1]), "=&v"(tr[2][0]), "=&v"(tr[2][1]), "=&v"(tr[3][0]), "=&v"(tr[3][1]), "=&v"(tr[4][0]), "=&v"(tr[4][1]), "=&v"(tr[5][0]), "=&v"(tr[5][1]), "=&v"(tr[6][0]), "=&v"(tr[6][1]), "=&v"(tr[7][0]), "=&v"(tr[7][1]), "=&v"(tr[8][0]), "=&v"(tr[8][1]) : "v"(a) : "memory"); }
#pragma unroll
        for (int vt = 0; vt < 9; ++vt) { u32x4 aw; aw.x = tr[vt][0].x; aw.y = tr[vt][0].y; aw.z = tr[vt][1].x; aw.w = tr[vt][1].y;
            ai[vt] = mfma16(__builtin_bit_cast(bf16x8, aw), pf, ai[vt]);
            const bf16x8 cf = *(const bf16x8*)(cst + (vt * 16 + fr) * 64 + kk * 32 + fq * 8);
            ae[vt] = mfma16(cf, qf[kk], ae[vt]); } }
    const float inter = fI[l];
#pragma unroll
    for (int vt = 0; vt < 9; ++vt) ai[vt] = ai[vt] + inter * ae[vt];
    const float den = __shfl(ai[8][0], fr);
    const float rD = 1.f / fmaxf(fabsf(den), expf(-(fb[l] + Ml)));
    float ss = 0.f;
#pragma unroll
    for (int vt = 0; vt < 8; ++vt) { ai[vt] = ai[vt] * rD; ss += (ai[vt][0] * ai[vt][0] + ai[vt][1] * ai[vt][1]) + (ai[vt][2] * ai[vt][2] + ai[vt][3] * ai[vt][3]); }
    ss += __shfl_xor(ss, 16); ss += __shfl_xor(ss, 32);
    const float rs = rsqrtf(ss * (1.f / 128.f) + 1e-6f);
#pragma unroll
    for (int vt = 0; vt < 8; ++vt) { const int v0 = vt * 16 + fq * 4; bf16_t* op = OG + (size_t)(ts + l) * 1024 + hh * 128 + v0;
        const u32x2 og = *(const u32x2*)op; const f32x4 nw = *(const f32x4*)(p.mnorm_w + hh * 128 + v0);
        u32x2 w; w.x = cvt_pk_bf16(bf_lo(og.x) * ai[vt][0] * rs * nw.x, bf_hi(og.x) * ai[vt][1] * rs * nw.y);
        w.y = cvt_pk_bf16(bf_lo(og.y) * ai[vt][2] * rs * nw.z, bf_hi(og.y) * ai[vt][3] * rs * nw.w);
        *(u32x2*)op = w; }
    __syncthreads();
}


struct PairOrder {
    StaticOrder so;
    __device__ bool next(int i, Unit& u) const { if (!so.next(i >> 1, u)) return false; if (i & 1) { u.pm += 64; u.pn += 4; } return true; }
    __device__ __forceinline__ void a_ready(const Unit&) const {}
    __device__ __forceinline__ void done(const Unit&) const {}
};
struct EpiMerge {
    static constexpr bool PERM = true, AFTER_DRAIN = false;
    const bf16_t *GA, *GM; bf16_t* Mg;
    __device__ __forceinline__ bool keep(const Unit& u) const { return u.pn < 4; }
    __device__ __forceinline__ void operator()(f32x4 (&acc)[2][2][4][2], const Unit& u, int ui, int wr, int wc, int fr, int fq) const {
        const bool first = u.pn < 4; const int pm = first ? u.pm : u.pm - 64, pn = first ? u.pn : u.pn - 4;
        const int row0 = pm * BM + wr * 64 + fr, col0 = pn * BM + wc * 32 + 8 * fq;
#pragma unroll
        for (int ai = 0; ai < 2; ++ai)
#pragma unroll
            for (int m = 0; m < 4; ++m)
#pragma unroll
                for (int bj = 0; bj < 2; ++bj) { const size_t idx = (size_t)(row0 + ai * HALF + m * 16) * 1024 + col0 + bj * HALF;
                    const u32x4 gm = *(const u32x4*)((first ? GA : GM) + idx);
                    float gmf[8] = {bf_lo(gm.x), bf_hi(gm.x), bf_lo(gm.y), bf_hi(gm.y), bf_lo(gm.z), bf_hi(gm.z), bf_lo(gm.w), bf_hi(gm.w)};
                    if (first) {
#pragma unroll
                        for (int i = 0; i < 4; ++i) { acc[ai][bj][m][0][i] *= gmf[i]; acc[ai][bj][m][1][i] *= gmf[4 + i]; } }
                    else { u32x4 w;
                        w.x = cvt_pk_bf16(acc[ai][bj][m][0][0] * gmf[0], acc[ai][bj][m][0][1] * gmf[1]); w.y = cvt_pk_bf16(acc[ai][bj][m][0][2] * gmf[2], acc[ai][bj][m][0][3] * gmf[3]);
                        w.z = cvt_pk_bf16(acc[ai][bj][m][1][0] * gmf[4], acc[ai][bj][m][1][1] * gmf[5]); w.w = cvt_pk_bf16(acc[ai][bj][m][1][2] * gmf[6], acc[ai][bj][m][1][3] * gmf[7]);
                        *(u32x4*)(Mg + idx) = w; } }
    }
};
struct EpiOut {
    static constexpr bool PERM = false, AFTER_DRAIN = false;
    const float* x; float* out;
    __device__ __forceinline__ bool keep(const Unit&) const { return false; }
    __device__ __forceinline__ void operator()(const f32x4 (&acc)[2][2][4][2], const Unit& u, int ui, int wr, int wc, int fr, int fq) const {
        const int row0 = u.pm * BM + wr * 64 + fr, col0 = u.pn * BM + wc * 32 + 4 * fq;
#pragma unroll
        for (int ai = 0; ai < 2; ++ai)
#pragma unroll
            for (int m = 0; m < 4; ++m) { const size_t ro = (size_t)(row0 + ai * HALF + m * 16) * 1024 + col0;
#pragma unroll
                for (int bj = 0; bj < 2; ++bj)
#pragma unroll
                    for (int n = 0; n < 2; ++n) { const f32x4 xv = *(const f32x4*)(x + ro + bj * HALF + n * 16); *(f32x4*)(out + ro + bj * HALF + n * 16) = acc[ai][bj][m][n] + xv; } }
    }
};

struct EpiOutNorm {
    static constexpr bool PERM = false, AFTER_DRAIN = true;
    const float* x; float* out; const float* fw; float* rowss; unsigned* pcnt;
    __device__ __forceinline__ bool keep(const Unit&) const { return false; }
    __device__ __forceinline__ void fused(f32x4 (&acc)[2][2][4][2], const Unit& u, int wr, int wc, int fr, int fq, PG8_LAS unsigned char*, int wid, int lane) const {
        const int row0 = u.pm * BM + wr * 64 + fr, col0 = u.pn * BM + wc * 32 + 4 * fq;
        float dummy = 0.f;
#pragma unroll
        for (int ai = 0; ai < 2; ++ai) { f32x4 xv[4][2][2];
#pragma unroll
            for (int m = 0; m < 4; ++m) { const size_t ro = (size_t)(row0 + ai * HALF + m * 16) * 1024 + col0;
#pragma unroll
                for (int bj = 0; bj < 2; ++bj)
#pragma unroll
                    for (int n = 0; n < 2; ++n) xv[m][bj][n] = *(const f32x4*)(x + ro + bj * HALF + n * 16); }
#pragma unroll
            for (int m = 0; m < 4; ++m) { float ss = 0.f;
#pragma unroll
                for (int bj = 0; bj < 2; ++bj)
#pragma unroll
                    for (int n = 0; n < 2; ++n) { const f32x4 v = acc[ai][bj][m][n] + xv[m][bj][n]; acc[ai][bj][m][n] = v; ss += (v.x * v.x + v.y * v.y) + (v.z * v.z + v.w * v.w); }
                ss += __shfl_xor(ss, 16); ss += __shfl_xor(ss, 32);
                if (fq == 0) dummy += __hip_atomic_fetch_add(rowss + row0 + ai * HALF + m * 16, ss, __ATOMIC_RELAXED, __HIP_MEMORY_SCOPE_AGENT); }
            __builtin_amdgcn_sched_barrier(0); }
        asm volatile("s_waitcnt vmcnt(0)" :: "v"(dummy) : "memory");
        __syncthreads();
        if (wid == 0 && lane == 0) { unsigned* cnt = pcnt + 64 * u.pm;
            (void)__hip_atomic_fetch_add(cnt, 1u, __ATOMIC_RELAXED, __HIP_MEMORY_SCOPE_AGENT);
            unsigned sp = 0;
            while (__hip_atomic_load(cnt, __ATOMIC_RELAXED, __HIP_MEMORY_SCOPE_AGENT) < 4u) { __builtin_amdgcn_s_sleep(8); if (++sp > (1u << 17)) break; } }
        __syncthreads();
        f32x4 wv[2][2];
#pragma unroll
        for (int bj = 0; bj < 2; ++bj)
#pragma unroll
            for (int n = 0; n < 2; ++n) wv[bj][n] = *(const f32x4*)(fw + col0 + bj * HALF + n * 16);
        float tot[2][4];
#pragma unroll
        for (int ai = 0; ai < 2; ++ai)
#pragma unroll
            for (int m = 0; m < 4; ++m) { tot[ai][m] = 0.f; if (fq == 0) tot[ai][m] = __hip_atomic_fetch_add(rowss + row0 + ai * HALF + m * 16, 0.0f, __ATOMIC_RELAXED, __HIP_MEMORY_SCOPE_AGENT); }
#pragma unroll
        for (int ai = 0; ai < 2; ++ai)
#pragma unroll
            for (int m = 0; m < 4; ++m) { const int row = row0 + ai * HALF + m * 16;
                const float rstd = rsqrtf(__shfl(tot[ai][m], fr) * (1.f / 1024.f) + 1e-6f);
                const size_t ro = (size_t)row * 1024 + col0;
#pragma unroll
                for (int bj = 0; bj < 2; ++bj)
#pragma unroll
                    for (int n = 0; n < 2; ++n) *(f32x4*)(out + ro + bj * HALF + n * 16) = acc[ai][bj][m][n] * rstd * wv[bj][n]; }
    }
};


#define XB_TMO      128
#define XB_XCNT(j)  (256  + 64 * (j))
#define XB_XSUB(j)  (1280 + 64 * (j))
#define XB_XGEN(j)  (2304 + 64 * (j))
#define XB_TOP      3328
#define XB_TOPGEN   3392
#define XCD_BAR_WORDS 3456
#define XB_SPIN_CAP (1u << 18)

__device__ __forceinline__ unsigned xb_ld(unsigned* p)              { return __hip_atomic_load(p, __ATOMIC_RELAXED, __HIP_MEMORY_SCOPE_AGENT); }
__device__ __forceinline__ unsigned xb_add(unsigned* p, unsigned v) { return __hip_atomic_fetch_add(p, v, __ATOMIC_RELAXED, __HIP_MEMORY_SCOPE_AGENT); }
__device__ __forceinline__ unsigned xb_xcc_id() { return (unsigned)__builtin_amdgcn_s_getreg((3 << 11) | 20) & 0xFu; }
#define XB_SPIN(cond, bar) do { unsigned _sp = 0; while (cond) { __builtin_amdgcn_s_sleep(1); \
    if ((++_sp & 255u) == 0u) { if (xb_ld(&(bar)[XB_TMO])) break; if (_sp > XB_SPIN_CAP) { atomicAdd(&(bar)[XB_TMO], 1u); break; } } } } while (0)

struct XcdBarrier {
    unsigned* bar; unsigned x;
    volatile LAS unsigned* st;
};

__device__ __forceinline__ XcdBarrier xcd_barrier_post(unsigned* bar, volatile LAS unsigned* st) {
    XcdBarrier b; b.bar = bar; b.x = xb_xcc_id(); b.st = st;
    if (threadIdx.x == 0) (void)xb_add(&bar[XB_XCNT(b.x)], 1u);
    return b;
}
__device__ __forceinline__ void xcd_barrier_complete(unsigned* bar, unsigned x, unsigned& nloc, unsigned& nx) {
    const unsigned G = gridDim.x * gridDim.y * gridDim.z;
    unsigned sum, cnt, mine, sp = 0u;
    for (;;) {
        sum = 0u; cnt = 0u; mine = 0u;
#pragma unroll
        for (unsigned j = 0; j < 16; ++j) { const unsigned c = xb_ld(&bar[XB_XCNT(j)]); sum += c; cnt += (c > 0u) ? 1u : 0u; mine = (j == x) ? c : mine; }
        if (sum == G) break;
        __builtin_amdgcn_s_sleep(1);
        if ((++sp & 255u) == 0u) { if (xb_ld(&bar[XB_TMO])) break; if (sp > XB_SPIN_CAP) { atomicAdd(&bar[XB_TMO], 1u); break; } }
    }
    nloc = mine > 0u ? mine : 1u; nx = cnt > 0u ? cnt : 1u;
}

__device__ __forceinline__ void xcd_barrier(const XcdBarrier& b) {
    asm volatile("s_waitcnt vmcnt(0)" ::: "memory");
    __syncthreads();
    if (threadIdx.x == 0) {
        unsigned* bar = b.bar;
        __builtin_amdgcn_s_waitcnt(0);
        unsigned nloc = b.st[0], nx = b.st[1];
        if (nloc == 0u) { xcd_barrier_complete(bar, b.x, nloc, nx); b.st[0] = nloc; b.st[1] = nx; }
        const unsigned old = xb_add(&bar[XB_XSUB(b.x)], 1u);
        const unsigned gen = old / nloc;
        if (old + 1u == (gen + 1u) * nloc) {
            __builtin_amdgcn_fence(__ATOMIC_RELEASE, "agent");
            asm volatile("s_waitcnt vmcnt(0)" ::: "memory");
            const unsigned og = xb_add(&bar[XB_TOP], 1u);
            const unsigned tg = og / nx;
            if (og + 1u == (tg + 1u) * nx) xb_add(&bar[XB_TOPGEN], 1u);
            else XB_SPIN(xb_ld(&bar[XB_TOPGEN]) == tg, bar);
            __builtin_amdgcn_fence(__ATOMIC_ACQUIRE, "agent");
            xb_add(&bar[XB_XGEN(b.x)], 1u);
            asm volatile("s_waitcnt vmcnt(0)" ::: "memory");
        } else {
            XB_SPIN(xb_ld(&bar[XB_XGEN(b.x)]) == gen, bar);
            __builtin_amdgcn_fence(__ATOMIC_ACQUIRE, "agent");
            asm volatile("s_waitcnt vmcnt(0)" ::: "memory");
        }
    }
    __syncthreads();
}

__global__ void __launch_bounds__(512, 2) mega(Params p) {
    extern __shared__ __attribute__((aligned(16))) unsigned char shm[];
    LAS unsigned char* lds = (LAS unsigned char*)shm;
    const int G = gridDim.x;
    volatile LAS unsigned* xbw = (volatile LAS unsigned*)(lds + 131072);
    if (threadIdx.x < 4) xbw[threadIdx.x] = 0u;
    __syncthreads();
    const XcdBarrier xb = xcd_barrier_post((unsigned*)(p.ws + OFF_BAR), xbw);
#ifndef PROBE_MASK
#define PROBE_MASK 0
#endif
    unsigned long long pt0 = PROBE_MASK ? wall_clock64() : 0ull;
#define PHASE(n) if (p.ph_lo <= (n) && (n) < p.ph_hi)
#define SEAM(n) if (PROBE_MASK) { if ((PROBE_MASK >> ((n) - 1)) & 1) { __syncthreads(); const unsigned long long pt1 = wall_clock64(); while (wall_clock64() - pt1 < pt1 - pt0) __builtin_amdgcn_s_sleep(8); } } \
    if (p.ph_lo < (n) && (n) < p.ph_hi) xcd_barrier(xb); if (PROBE_MASK) pt0 = wall_clock64();
    PHASE(0) phase0(p, lds, G);
    SEAM(1)
    PHASE(1) {
        Gemm g; g.A = (const bf16_t*)((unsigned char*)p.out + OUT_H); g.Bt = (const bf16_t*)((unsigned char*)p.out + OUT_WTIN); g.M = T_TOK; g.N = NPT; g.K = 1024;
        StaticOrder S; S.init(T_TOK, NPT, G, blockIdx.x);
        LAS float* biasl = (LAS float*)(lds + 131072 + 16);
        { const float* biasp = (const float*)(p.ws + OFF_BIASP); Unit u;
          for (int i = 0; i < BIAS_UNITS && S.next(i, u); ++i) if (threadIdx.x < 256) biasl[i * 256 + threadIdx.x] = biasp[u.pn * 256 + threadIdx.x];
          __syncthreads(); }
        Epi1 E; E.ws = p.ws; E.biasl = biasl;
        gemm_phase<Epi1, StaticOrder, true, true>(lds, g, S, E);
    }
    SEAM(2)
    PHASE(2) {
        for (int it = blockIdx.x; it < 512; it += G) attn_item(p, lds, it);
        for (int itp = blockIdx.x; itp < 1024; itp += G) mlstm_pass1(p, lds, itp);
    }
    SEAM(3)
    PHASE(3) mlstm_scan(p, G);
    SEAM(4)
    PHASE(4) { for (int itp = blockIdx.x; itp < 1024; itp += G) mlstm_pass3(p, lds, itp); }
    SEAM(5)
    PHASE(5) {
        Gemm g; g.A = (const bf16_t*)(p.ws + OFF_Z); g.Bt = (const bf16_t*)(p.ws + OFF_WAT); g.M = T_TOK; g.N = 1024; g.K = 1024;
        PairOrder S; S.so.init(T_TOK, 1024, G, blockIdx.x);
        EpiMerge E; E.GA = (const bf16_t*)(p.ws + OFF_GA); E.GM = (const bf16_t*)(p.ws + OFF_GM); E.Mg = (bf16_t*)(p.ws + OFF_Q);
        gemm_phase<EpiMerge, PairOrder, true, true>(lds, g, S, E);
    }
    SEAM(6)
    PHASE(6) {
        Gemm g; g.A = (const bf16_t*)(p.ws + OFF_Q); g.Bt = (const bf16_t*)(p.ws + OFF_WOT); g.M = T_TOK; g.N = 1024; g.K = 1024;
        StaticOrder S; S.init(T_TOK, 1024, G, blockIdx.x);
        if (G == 256) { EpiOutNorm E; E.x = p.x; E.out = p.out; E.fw = p.fnorm_w; E.rowss = (float*)(p.ws + OFF_ROWSS); E.pcnt = (unsigned*)(p.ws + OFF_PCNT);
            gemm_phase<EpiOutNorm, StaticOrder, false, true>(lds, g, S, E); }
        else { EpiOut E; E.x = p.x; E.out = p.out; gemm_phase<EpiOut, StaticOrder, true, true>(lds, g, S, E); }
    }
    if (G != 256) {
    SEAM(7)
    PHASE(7) {
        const int lane = threadIdx.x & 63, gw = blockIdx.x * 8 + (threadIdx.x >> 6);
        f32x4 nwv[4];
#pragma unroll
        for (int j = 0; j < 4; ++j) nwv[j] = ((const f32x4*)p.fnorm_w)[64 * j + lane];
        for (int row = gw; row < T_TOK; row += G * 32) {
            f32x4 v[4][4];
#pragma unroll
            for (int i = 0; i < 4; ++i) { const int r = row + i * G * 8;
                if (r < T_TOK) {
#pragma unroll
                    for (int j = 0; j < 4; ++j) v[i][j] = ((const f32x4*)(p.out + (size_t)r * 1024) + lane)[64 * j]; } }
#pragma unroll
            for (int i = 0; i < 4; ++i) { const int r = row + i * G * 8;
                if (r < T_TOK) { float ss = 0.f;
#pragma unroll
                    for (int j = 0; j < 4; ++j) ss += (v[i][j].x * v[i][j].x + v[i][j].y * v[i][j].y) + (v[i][j].z * v[i][j].z + v[i][j].w * v[i][j].w);
                    ss = wave_sum(ss);
                    const float rstd = rsqrtf(ss * (1.f / 1024.f) + 1e-6f);
#pragma unroll
                    for (int j = 0; j < 4; ++j) ((f32x4*)(p.out + (size_t)r * 1024) + lane)[64 * j] = v[i][j] * rstd * nwv[j]; } }
        }
    }
    }
}

extern "C" void kernel_launch(void* const* d_in, const int* in_sizes, int n_in, void* d_out, int out_size, void* d_ws, size_t ws_size, hipStream_t stream) {
    static int grid = 0;
    if (grid == 0) {
        if (n_in != 12 || out_size != T_TOK * 1024 || ws_size < WS_END) { fprintf(stderr, "kernel_launch: unexpected shapes (n_in %d out %d ws %zu)\n", n_in, out_size, ws_size); grid = -1; return; }
        int dev = 0, cus = 0, per_cu = 0;
        (void)hipGetDevice(&dev); (void)hipDeviceGetAttribute(&cus, hipDeviceAttributeMultiprocessorCount, dev);
        if (hipFuncSetAttribute((const void*)mega, hipFuncAttributeMaxDynamicSharedMemorySize, LDS_BYTES) != hipSuccess) { fprintf(stderr, "kernel_launch: hipFuncSetAttribute failed\n"); grid = -1; return; }
        if (hipOccupancyMaxActiveBlocksPerMultiprocessor(&per_cu, (const void*)mega, 512, LDS_BYTES) != hipSuccess || per_cu < 1) { fprintf(stderr, "kernel_launch: occupancy query failed (%d)\n", per_cu); grid = -1; return; }
        grid = cus * per_cu;
    }
    if (grid < 0) return;
    if (hipMemsetAsync((char*)d_ws + OFF_BAR, 0, (size_t)(OFF_ROWSS + 65536 - OFF_BAR), stream) != hipSuccess) { fprintf(stderr, "kernel_launch: memset failed\n"); return; }
    Params p{};
    p.x = (const float*)d_in[0]; p.norm_w = (const float*)d_in[1]; p.w_in = (const float*)d_in[2]; p.b_in = (const float*)d_in[3]; p.sinks = (const float*)d_in[4];
    p.conv_w = (const float*)d_in[5]; p.conv_b = (const float*)d_in[6]; p.mnorm_w = (const float*)d_in[7]; p.w_ba = (const float*)d_in[8]; p.w_bm = (const float*)d_in[9];
    p.w_out = (const float*)d_in[10]; p.fnorm_w = (const float*)d_in[11];
    p.out = (float*)d_out; p.ws = (unsigned char*)d_ws; p.ph_lo = 0; p.ph_hi = 8;
    void* args[] = {&p};
    hipError_t e = hipLaunchCooperativeKernel((const void*)mega, dim3(grid), dim3(512), args, LDS_BYTES, stream);
    if (e != hipSuccess) fprintf(stderr, "kernel_launch: cooperative launch failed: %s (grid %d)\n", hipGetErrorString(e), grid);
}
```

```cpp
#include <hip/hip_runtime.h>
#include <cstdio>
#include <cmath>
namespace pg8 {
#define PG8_LAS __attribute__((address_space(3)))
typedef unsigned short bf16_t;
typedef short bf16x8 __attribute__((ext_vector_type(8)));
typedef float f32x4 __attribute__((ext_vector_type(4)));
typedef unsigned u32x4 __attribute__((ext_vector_type(4)));
constexpr int BM = 256, BK = 64, HALF = 128, HTB = HALF * BK * 2  , STAGE_BYTES = 8 * HTB, NXCD = 8, WGM = 8;

__host__ __device__ __forceinline__ int lds_byte(int r, int c) { const int st = (r >> 4) * 2 + (c >> 5), rr = r & 15, cc = c & 31, ob = rr * 64 + cc * 2; return st * 1024 + (ob ^ (((ob >> 9) & 1) << 5)); }
__host__ __device__ __forceinline__ void stage_rc(int b, int& R, int& C) { const int st = b / 1024, sb = b % 1024, swz = sb ^ (((sb >> 9) & 1) << 5); R = (st >> 1) * 16 + swz / 64; C = (st & 1) * 32 + (swz % 64) / 2; }
__host__ __device__ __forceinline__ int perm32(int rho) { const int n = rho >> 4, i = rho & 15; return 8 * (i >> 2) + 4 * n + (i & 3); }

struct Unit { int pm, pn; };
struct Gemm { const bf16_t* A; const bf16_t* Bt; int M, N, K; };

struct StaticOrder {
    int nM, nN, nwg, G, c;
    __host__ __device__ void init(int M, int N, int G_, int c_) { nM = M / BM; nN = N / BM; nwg = nM * nN; G = G_; c = c_; }
    __host__ __device__ bool next(int i, Unit& u) const {
        const long L = (long)i * G + c; if (L >= nwg) return false;
        int wgid = (int)L; { const int q = nwg / NXCD, r = nwg % NXCD, xcd = wgid % NXCD, off = wgid / NXCD; wgid = (xcd < r ? xcd * (q + 1) : r * (q + 1) + (xcd - r) * q) + off; }
        const int nig = WGM * nN, gid = wgid / nig, fm = gid * WGM, gsz = (nM - fm) < WGM ? (nM - fm) : WGM;
        u.pm = fm + ((wgid % nig) % gsz); u.pn = (wgid % nig) / gsz; return true;
    }
    __device__ __forceinline__ void a_ready(const Unit&) const {}
    __device__ __forceinline__ void done(const Unit&) const {}
};
__device__ __forceinline__ unsigned cvt_pk_bf16(float lo, float hi) { unsigned r; asm volatile("v_cvt_pk_bf16_f32 %0, %1, %2" : "=v"(r) : "v"(lo), "v"(hi)); return r; }
template <class Epi, class Sched, bool ALIGN_EPI = false, bool SP2 = false>
__device__ __forceinline__ void gemm_phase(PG8_LAS unsigned char* lds, const Gemm g, const Sched& S, const Epi& E) {
    const int tid = threadIdx.x, wid = __builtin_amdgcn_readfirstlane(tid >> 6), lane = tid & 63, wr = wid >> 2, wc = wid & 3, fr = lane & 15, fq = lane >> 4;
    const int K = g.K, nt = K / BK;
    unsigned voffA[2], voffB[2];
#pragma unroll
    for (int i = 0; i < 2; ++i) { int R, C; stage_rc(tid * 16 + i * 8192, R, C); const int Rb = Epi::PERM ? ((R & ~31) + perm32(R & 31)) : R;
        voffA[i] = (unsigned)(R * K + C) * 2u; voffB[i] = (unsigned)(Rb * K + C) * 2u; }
    const size_t kstep = (size_t)(BK * 2);
    const size_t hstep = (size_t)HALF * K * 2;
    const size_t tstep = 2 * hstep;
    const unsigned ldsw = (unsigned)wid * 1024u;
    const int aoff = lds_byte(wr * 64 + fr, fq * 8), boff = lds_byte(wc * 32 + fr, fq * 8);
#define PG8_SA(b, h) (((b) * 2 + (h)) * HTB)
#define PG8_SB(b, h) ((4 + (b) * 2 + (h)) * HTB)
#define PG8_STAGE(bufoff, gbase, voff) do { _Pragma("unroll") for (int _i = 0; _i < 2; ++_i) \
        __builtin_amdgcn_global_load_lds((const unsigned*)((const char*)(gbase) + (voff)[_i]), (PG8_LAS unsigned*)(lds + (bufoff) + ldsw + _i * 8192), 16, 0, 0); } while (0)
#define PG8_LDA(dst, b, h) do { _Pragma("unroll") for (int m = 0; m < 4; ++m) _Pragma("unroll") for (int k = 0; k < 2; ++k) dst[m][k] = *(const PG8_LAS bf16x8*)(lds + PG8_SA(b, h) + aoff + m * 2048 + k * 1024); } while (0)
#define PG8_LDB(dst, b, h) do { _Pragma("unroll") for (int n = 0; n < 2; ++n) _Pragma("unroll") for (int k = 0; k < 2; ++k) dst[n][k] = *(const PG8_LAS bf16x8*)(lds + PG8_SB(b, h) + boff + n * 2048 + k * 1024); } while (0)
#define PG8_MMA(ai, bj, At, Bt) do { __builtin_amdgcn_s_setprio(1); _Pragma("unroll") for (int m = 0; m < 4; ++m) _Pragma("unroll") for (int n = 0; n < 2; ++n) _Pragma("unroll") for (int k = 0; k < 2; ++k) \
        acc[ai][bj][m][n] = __builtin_amdgcn_mfma_f32_16x16x32_bf16(Bt[n][k], At[m][k], acc[ai][bj][m][n], 0, 0, 0); __builtin_amdgcn_s_setprio(0); } while (0)
#define PG8_WAIT_V(n) asm volatile("s_waitcnt vmcnt(" #n ")" ::: "memory")
#define PG8_WAIT_L(n) asm volatile("s_waitcnt lgkmcnt(" #n ")" ::: "memory")
#define PG8_BAR __builtin_amdgcn_s_barrier()
#define PG8_SCHED __builtin_amdgcn_sched_barrier(0)
    Unit cur, nxt; int ui = 0;
    if (!S.next(0, cur)) return;
    f32x4 acc[2][2][4][2];
#pragma unroll
    for (int a = 0; a < 2; ++a)
#pragma unroll
        for (int b = 0; b < 2; ++b)
#pragma unroll
            for (int m = 0; m < 4; ++m)
#pragma unroll
                for (int n = 0; n < 2; ++n) acc[a][b][m][n] = (f32x4){0.f, 0.f, 0.f, 0.f};
    bf16x8 At[4][2], B0[2][2], B1[2][2];
    const char* cA = (const char*)g.A + (size_t)cur.pm * tstep; const char* cB = (const char*)g.Bt + (size_t)cur.pn * tstep;
    S.a_ready(cur);
    if constexpr (SP2) {
        PG8_STAGE(PG8_SB(0, 0), cB, voffB); PG8_STAGE(PG8_SB(0, 1), cB + hstep, voffB); PG8_STAGE(PG8_SA(0, 0), cA, voffA); PG8_STAGE(PG8_SA(0, 1), cA + hstep, voffA);
        if (wr == 1) PG8_BAR;
        PG8_WAIT_V(2); PG8_BAR;
        PG8_STAGE(PG8_SB(1, 0), cB + kstep, voffB); PG8_STAGE(PG8_SA(1, 0), cA + kstep, voffA); PG8_STAGE(PG8_SB(1, 1), cB + hstep + kstep, voffB);
        PG8_WAIT_V(6); PG8_BAR;
    } else {
        PG8_STAGE(PG8_SB(0, 0), cB, voffB); PG8_STAGE(PG8_SA(0, 0), cA, voffA); PG8_STAGE(PG8_SB(0, 1), cB + hstep, voffB); PG8_STAGE(PG8_SA(0, 1), cA + hstep, voffA);
        if (wr == 1) PG8_BAR;
        PG8_WAIT_V(4); PG8_BAR;
        PG8_STAGE(PG8_SB(1, 0), cB + kstep, voffB); PG8_STAGE(PG8_SA(1, 0), cA + kstep, voffA); PG8_STAGE(PG8_SB(1, 1), cB + hstep + kstep, voffB);
        PG8_WAIT_V(6); PG8_BAR;
    }
    for (;;) {
        const bool has_next = S.next(ui + 1, nxt);
        const char* nA = has_next ? (const char*)g.A + (size_t)nxt.pm * tstep : cA; const char* nB = has_next ? (const char*)g.Bt + (size_t)nxt.pn * tstep : cB;
        for (int t = 0; t < nt; t += 2) {
            const bool last = (t == nt - 2);
            const char* a1 = cA + (size_t)(t + 1) * kstep;
            const char* a2 = last ? nA : cA + (size_t)(t + 2) * kstep; const char* b2 = last ? nB : cB + (size_t)(t + 2) * kstep;
            const char* a3 = a2 + kstep; const char* b3 = b2 + kstep;
            if (last && has_next) S.a_ready(nxt);
            if constexpr (SP2) {
            PG8_LDB(B0, 0, 0); PG8_LDB(B1, 0, 1); PG8_SCHED; PG8_LDA(At, 0, 0); PG8_STAGE(PG8_SA(1, 1), a1 + hstep, voffA);
            PG8_WAIT_V(8); PG8_WAIT_L(0); PG8_BAR; PG8_MMA(0, 0, At, B0); PG8_MMA(0, 1, At, B1); PG8_BAR; PG8_SCHED;
            PG8_LDA(At, 0, 1); PG8_STAGE(PG8_SB(0, 0), b2, voffB); PG8_STAGE(PG8_SB(0, 1), b2 + hstep, voffB); PG8_STAGE(PG8_SA(0, 0), a2, voffA);
            PG8_WAIT_V(8); PG8_WAIT_L(0); PG8_BAR; PG8_MMA(1, 0, At, B0); PG8_MMA(1, 1, At, B1); PG8_BAR; PG8_SCHED;
            PG8_LDB(B0, 1, 0); PG8_LDB(B1, 1, 1); PG8_SCHED; PG8_LDA(At, 1, 0); PG8_STAGE(PG8_SA(0, 1), a2 + hstep, voffA);
            PG8_WAIT_V(8); PG8_WAIT_L(0); PG8_BAR; PG8_MMA(0, 0, At, B0); PG8_MMA(0, 1, At, B1); PG8_BAR; PG8_SCHED;
            PG8_LDA(At, 1, 1); PG8_STAGE(PG8_SB(1, 0), b3, voffB); PG8_STAGE(PG8_SB(1, 1), b3 + hstep, voffB); PG8_STAGE(PG8_SA(1, 0), a3, voffA);
            PG8_WAIT_V(8); PG8_WAIT_L(0); PG8_BAR; PG8_MMA(1, 0, At, B0); PG8_MMA(1, 1, At, B1); PG8_BAR; PG8_SCHED;
            } else {
            PG8_LDB(B0, 0, 0); PG8_SCHED; PG8_LDA(At, 0, 0); PG8_STAGE(PG8_SA(1, 1), a1 + hstep, voffA);
            PG8_WAIT_L(8); PG8_BAR; PG8_WAIT_L(0); PG8_MMA(0, 0, At, B0); PG8_BAR; PG8_SCHED;
            PG8_LDB(B1, 0, 1); PG8_STAGE(PG8_SB(0, 0), b2, voffB);
            PG8_BAR; PG8_WAIT_L(0); PG8_MMA(0, 1, At, B1); PG8_BAR;
            PG8_LDA(At, 0, 1); PG8_STAGE(PG8_SA(0, 0), a2, voffA);
            PG8_BAR; PG8_WAIT_L(0); PG8_MMA(1, 0, At, B0); PG8_BAR; PG8_SCHED;
            PG8_STAGE(PG8_SB(0, 1), b2 + hstep, voffB);
            PG8_WAIT_V(6); PG8_BAR; PG8_MMA(1, 1, At, B1); PG8_BAR;
            PG8_LDB(B0, 1, 0); PG8_SCHED; PG8_LDA(At, 1, 0); PG8_STAGE(PG8_SA(0, 1), a2 + hstep, voffA);
            PG8_WAIT_L(8); PG8_BAR; PG8_WAIT_L(0); PG8_MMA(0, 0, At, B0); PG8_BAR; PG8_SCHED;
            PG8_LDB(B1, 1, 1); PG8_STAGE(PG8_SB(1, 0), b3, voffB);
            PG8_BAR; PG8_WAIT_L(0); PG8_MMA(0, 1, At, B1); PG8_BAR;
            PG8_LDA(At, 1, 1); PG8_STAGE(PG8_SA(1, 0), a3, voffA);
            PG8_BAR; PG8_WAIT_L(0); PG8_MMA(1, 0, At, B0); PG8_BAR; PG8_SCHED;
            PG8_STAGE(PG8_SB(1, 1), b3 + hstep, voffB);
            PG8_WAIT_V(6); PG8_BAR; PG8_MMA(1, 1, At, B1); PG8_BAR;
            }
        }
        if constexpr (ALIGN_EPI) { if (wr == 0) PG8_BAR; }
        if constexpr (!Epi::AFTER_DRAIN) { E(acc, cur, ui, wr, wc, fr, fq); S.done(cur); }
        if (!has_next) break;
        if (!E.keep(cur))
#pragma unroll
        for (int a = 0; a < 2; ++a)
#pragma unroll
            for (int b = 0; b < 2; ++b)
#pragma unroll
                for (int m = 0; m < 4; ++m)
#pragma unroll
                    for (int n = 0; n < 2; ++n) acc[a][b][m][n] = (f32x4){0.f, 0.f, 0.f, 0.f};
        cur = nxt; cA = nA; cB = nB; ++ui;
        if constexpr (ALIGN_EPI) { if (wr == 1) PG8_BAR; }
    }
    PG8_WAIT_V(0);
    if constexpr (!ALIGN_EPI) { if (wr == 0) PG8_BAR; }
    PG8_BAR;
    if constexpr (Epi::AFTER_DRAIN) { E.fused(acc, cur, wr, wc, fr, fq, lds, wid, lane); S.done(cur); }
#undef PG8_SA
#undef PG8_SB
#undef PG8_STAGE
#undef PG8_LDA
#undef PG8_LDB
#undef PG8_MMA
#undef PG8_WAIT_V
#undef PG8_WAIT_L
#undef PG8_BAR
#undef PG8_SCHED
}
}

using namespace pg8;
#define LAS __attribute__((address_space(3)))
typedef unsigned u32x2 __attribute__((ext_vector_type(2)));

constexpr int T_TOK = 16384, PROJ = 8720, NP = 8704, NPT = 8960;
constexpr size_t MiB = 1ull << 20;
constexpr size_t OFF_Q = 0, OFF_Z = 32 * MiB, OFF_OG = 64 * MiB, OFF_GA = 96 * MiB, OFF_GM = 128 * MiB, OFF_MV = 160 * MiB,
                 OFF_MQ = 192 * MiB, OFF_MK = 208 * MiB, OFF_K = 224 * MiB, OFF_V = 232 * MiB, OFF_WAT = 240 * MiB,
                 OFF_WOT = 244 * MiB, OFF_IF = 246 * MiB, OFF_BIASP = 247 * MiB, OFF_MLOC = OFF_BIASP + 65536,
                 OFF_GSUM = OFF_MLOC + 8192, OFF_MPREV = OFF_GSUM + 8192, OFF_BAR = OFF_MPREV + 8192, OFF_PCNT = OFF_BAR + 16384, OFF_ROWSS = OFF_PCNT + 16384, WS_END = OFF_ROWSS + 65536;
constexpr size_t OUT_H = 0, OUT_WTIN = 32 * MiB, OUT_CST = 0;
constexpr int BIAS_UNITS = 12;
constexpr int LDS_BYTES = 131072 + 16 + BIAS_UNITS * 1024;
constexpr int HSZ = 49408;

struct Params {
    const float *x, *norm_w, *w_in, *b_in, *sinks, *conv_w, *conv_b, *mnorm_w, *w_ba, *w_bm, *w_out, *fnorm_w;
    float* out; unsigned char* ws;
    int ph_lo, ph_hi;
};

__device__ __forceinline__ float bf_lo(unsigned w) { return __uint_as_float(w << 16); }
__device__ __forceinline__ float bf_hi(unsigned w) { return __uint_as_float(w & 0xffff0000u); }
__device__ __forceinline__ float bf2f(bf16_t b) { return __uint_as_float(((unsigned)b) << 16); }
__device__ __forceinline__ bf16_t f2bf(float f) { unsigned u = __float_as_uint(f); u += 0x7fffu + ((u >> 16) & 1u); return (bf16_t)(u >> 16); }
__device__ __forceinline__ float sigm(float x) { return __builtin_amdgcn_rcpf(1.f + __builtin_amdgcn_exp2f(-1.44269504f * x)); }
__device__ __forceinline__ float silu(float x) { return x * __builtin_amdgcn_rcpf(1.f + __builtin_amdgcn_exp2f(-1.44269504f * x)); }
__device__ __forceinline__ float wave_sum(float v) {
#pragma unroll
    for (int o = 1; o < 64; o <<= 1) v += __shfl_xor(v, o);
    return v;
}
__device__ __forceinline__ float wave_max(float v) {
#pragma unroll
    for (int o = 1; o < 64; o <<= 1) v = fmaxf(v, __shfl_xor(v, o));
    return v;
}
__device__ __forceinline__ f32x4 mfma16(bf16x8 a, bf16x8 b, f32x4 c) { return __builtin_amdgcn_mfma_f32_16x16x32_bf16(a, b, c, 0, 0, 0); }

__device__ __forceinline__ int src_col(int np) {
    if (np < 4608) return np;
    if (np < 6656) { const int t = (np - 4608) >> 8, r = np & 255; return (r < 128) ? (4624 + 128 * t + r) : (5648 + 128 * t + (r - 128)); }
    if (np >= 8704) return 4608 + (np - 8704);
    { const int t = (np - 6656) >> 8, r = np & 255; return (r < 128) ? (6672 + 128 * t + r) : (7696 + 128 * t + (r - 128)); }
}

__device__ __forceinline__ void transpose_item(const float* W, int N, int n_src0, bf16_t* WT, int row0, int k0, LAS float* scr, int lane) {
    f32x4 tv[8]; const int kr = lane >> 3, nc = (lane & 7) * 4;
#pragma unroll
    for (int i = 0; i < 8; ++i) tv[i] = __builtin_nontemporal_load((const f32x4*)(W + (size_t)(k0 + kr + 8 * i) * N + n_src0 + nc));
#pragma unroll
    for (int i = 0; i < 8; ++i) { LAS float* d = scr + (kr + 8 * i) * 33 + nc; d[0] = tv[i].x; d[1] = tv[i].y; d[2] = tv[i].z; d[3] = tv[i].w; }
    asm volatile("s_waitcnt lgkmcnt(0)" ::: "memory");
    const int c = lane & 7;
#pragma unroll
    for (int j = 0; j < 4; ++j) { const int n = (lane >> 3) + 8 * j; const LAS float* s = scr + (8 * c) * 33 + n;
        u32x4 o; o.x = cvt_pk_bf16(s[0], s[33]); o.y = cvt_pk_bf16(s[66], s[99]); o.z = cvt_pk_bf16(s[132], s[165]); o.w = cvt_pk_bf16(s[198], s[231]);
        *(u32x4*)(WT + (size_t)(row0 + n) * 1024 + k0 + 8 * c) = o; }
    asm volatile("s_waitcnt lgkmcnt(0)" ::: "memory");
}

__device__ __forceinline__ void phase0(const Params& p, LAS unsigned char* lds, int G) {
    const int tid = threadIdx.x, lane = tid & 63, wave = tid >> 6;
    const int gw = blockIdx.x * 8 + wave, NGW = G * 8;
    bf16_t* WtIn = (bf16_t*)((unsigned char*)p.out + OUT_WTIN);
    bf16_t* WaT = (bf16_t*)(p.ws + OFF_WAT);
    bf16_t* WoT = (bf16_t*)(p.ws + OFF_WOT);
    LAS float* scr = (LAS float*)lds + wave * (64 * 33);
    constexpr int NBLK = NP / 32 + 1, I_IN = 16 * NBLK, I_SQ = 16 * 32;
    for (int it = gw; it < I_IN + 3 * I_SQ; it += NGW) {
        if (it < I_IN) { const int kb = it / NBLK, nb = it % NBLK; transpose_item(p.w_in, PROJ, src_col(nb * 32), WtIn, nb * 32, kb * 64, scr, lane); }
        else { int r = it - I_IN; const int mtx = r / I_SQ; r %= I_SQ; const int kb = r / 32, nb = r % 32;
            const float* W = mtx == 0 ? p.w_ba : (mtx == 1 ? p.w_bm : p.w_out);
            bf16_t* WT = mtx == 2 ? WoT : WaT; const int row0 = (mtx == 1 ? 1024 : 0) + nb * 32;
            transpose_item(W, 1024, nb * 32, WT, row0, kb * 64, scr, lane); }
    }
    float* biasp = (float*)(p.ws + OFF_BIASP);
    for (int i = blockIdx.x * 512 + tid; i < NP + 32; i += G * 512) biasp[i] = p.b_in[src_col(i)];
    bf16_t* H = (bf16_t*)((unsigned char*)p.out + OUT_H);
    f32x4 nwv[4], nxt[4];
#pragma unroll
    for (int j = 0; j < 4; ++j) { nwv[j] = ((const f32x4*)p.norm_w)[64 * j + lane]; nxt[j] = __builtin_nontemporal_load((const f32x4*)(p.x + (size_t)gw * 1024) + lane + 64 * j); }
    for (int row = gw; row < T_TOK; row += NGW) {
        f32x4 v[4]; float ss = 0.f;
#pragma unroll
        for (int j = 0; j < 4; ++j) v[j] = nxt[j];
        if (row + NGW < T_TOK) {
#pragma unroll
            for (int j = 0; j < 4; ++j) nxt[j] = __builtin_nontemporal_load((const f32x4*)(p.x + (size_t)(row + NGW) * 1024) + lane + 64 * j); }
#pragma unroll
        for (int j = 0; j < 4; ++j) ss += (v[j].x * v[j].x + v[j].y * v[j].y) + (v[j].z * v[j].z + v[j].w * v[j].w);
        ss = wave_sum(ss);
        const float rstd = rsqrtf(ss * (1.f / 1024.f) + 1e-6f);
#pragma unroll
        for (int j = 0; j < 4; ++j) { const f32x4 nw = nwv[j]; v[j] = v[j] * rstd * nw;
            u32x2 o; o.x = cvt_pk_bf16(v[j].x, v[j].y); o.y = cvt_pk_bf16(v[j].z, v[j].w);
            *((u32x2*)(H + (size_t)row * 1024) + 64 * j + lane) = o; }
    }
}

struct Epi1 {
    static constexpr bool PERM = true, AFTER_DRAIN = false;
    unsigned char* ws; const LAS float* biasl;
    __device__ __forceinline__ bool keep(const Unit&) const { return false; }
    __device__ __forceinline__ void operator()(const f32x4 (&acc)[2][2][4][2], const Unit& u, int ui, int wr, int wc, int fr, int fq) const {
        const int pn = u.pn, row0 = u.pm * BM + wr * 64 + fr, lc = wc * 32 + 8 * fq;
        f32x4 bv[2][2];
#pragma unroll
        for (int bj = 0; bj < 2; ++bj)
#pragma unroll
            for (int n = 0; n < 2; ++n) bv[bj][n] = *(const LAS f32x4*)(biasl + ui * 256 + bj * HALF + lc + 4 * n);
        if (pn == 34) {
            if (wc == 0 && fq < 2) { float* IF = (float*)(ws + OFF_IF);
#pragma unroll
                for (int ai = 0; ai < 2; ++ai)
#pragma unroll
                    for (int m = 0; m < 4; ++m) { float* gp = IF + (size_t)(row0 + ai * HALF + m * 16) * 16 + 8 * fq;
                        *(f32x4*)gp = acc[ai][0][m][0] + bv[0][0]; *(f32x4*)(gp + 4) = acc[ai][0][m][1] + bv[0][1]; } }
            return;
        }
        if (pn >= 26) {
            bf16_t* RA = (bf16_t*)(ws + OFF_GA); bf16_t* GMb = (bf16_t*)(ws + OFF_GM); const int cb = (pn - 26) * 128 + lc;
#pragma unroll
            for (int ai = 0; ai < 2; ++ai)
#pragma unroll
                for (int m = 0; m < 4; ++m) { float ra[8], gm[8];
#pragma unroll
                    for (int n = 0; n < 2; ++n)
#pragma unroll
                        for (int i = 0; i < 4; ++i) { const float a = acc[ai][0][m][n][i] + bv[0][n][i], b = acc[ai][1][m][n][i] + bv[1][n][i];
                            const float da = 1.f + __builtin_amdgcn_exp2f(-1.44269504f * a), db = 1.f + __builtin_amdgcn_exp2f(-1.44269504f * b);
                            ra[4 * n + i] = db * __builtin_amdgcn_rcpf(da); gm[4 * n + i] = __builtin_amdgcn_rcpf(db); }
                    u32x4 w; w.x = cvt_pk_bf16(ra[0], ra[1]); w.y = cvt_pk_bf16(ra[2], ra[3]); w.z = cvt_pk_bf16(ra[4], ra[5]); w.w = cvt_pk_bf16(ra[6], ra[7]);
                    const size_t o = (size_t)(row0 + ai * HALF + m * 16) * 1024 + cb;
                    *(u32x4*)(RA + o) = w;
                    w.x = cvt_pk_bf16(gm[0], gm[1]); w.y = cvt_pk_bf16(gm[2], gm[3]); w.z = cvt_pk_bf16(gm[4], gm[5]); w.w = cvt_pk_bf16(gm[6], gm[7]);
                    *(u32x4*)(GMb + o) = w; }
            return;
        }
        if (pn >= 18 && pn < 26) {
            bf16_t* OG = (bf16_t*)(ws + OFF_OG); const int cb = (pn - 18) * 128 + lc;
#pragma unroll
            for (int ai = 0; ai < 2; ++ai)
#pragma unroll
                for (int m = 0; m < 4; ++m) { float r[8];
#pragma unroll
                    for (int n = 0; n < 2; ++n)
#pragma unroll
                        for (int i = 0; i < 4; ++i) { const float o = acc[ai][0][m][n][i] + bv[0][n][i], z = acc[ai][1][m][n][i] + bv[1][n][i]; r[4 * n + i] = sigm(o) * silu(z); }
                    u32x4 w; w.x = cvt_pk_bf16(r[0], r[1]); w.y = cvt_pk_bf16(r[2], r[3]); w.z = cvt_pk_bf16(r[4], r[5]); w.w = cvt_pk_bf16(r[6], r[7]);
                    *(u32x4*)(OG + (size_t)(row0 + ai * HALF + m * 16) * 1024 + cb) = w; }
            return;
        }
        size_t off; int ld, c0, act;
        if (pn < 4) { off = OFF_Q; ld = 1024; c0 = pn * 256; act = 1; }
        else if (pn == 4) { off = OFF_K; ld = 256; c0 = 0; act = 0; }
        else if (pn == 5) { off = OFF_V; ld = 256; c0 = 0; act = 0; }
        else if (pn < 10) { off = OFF_Z; ld = 1024; c0 = (pn - 6) * 256; act = 2; }
        else if (pn < 12) { off = OFF_MQ; ld = 512; c0 = (pn - 10) * 256; act = 0; }
        else if (pn < 14) { off = OFF_MK; ld = 512; c0 = (pn - 12) * 256; act = 0; }
        else { off = OFF_MV; ld = 1024; c0 = (pn - 14) * 256; act = 0; }
        bf16_t* dst = (bf16_t*)(ws + off) + c0 + lc;
#pragma unroll
        for (int ai = 0; ai < 2; ++ai)
#pragma unroll
            for (int m = 0; m < 4; ++m) { bf16_t* rowp = dst + (size_t)(row0 + ai * HALF + m * 16) * ld;
#pragma unroll
                for (int bj = 0; bj < 2; ++bj) { f32x4 v0 = acc[ai][bj][m][0] + bv[bj][0], v1 = acc[ai][bj][m][1] + bv[bj][1];
                    if (act == 1) { v0 = v0 * 0.18033688f; v1 = v1 * 0.18033688f; }
                    else if (act == 2) {
#pragma unroll
                        for (int i = 0; i < 4; ++i) { v0[i] = silu(v0[i]); v1[i] = silu(v1[i]); } }
                    else if (act == 3) {
#pragma unroll
                        for (int i = 0; i < 4; ++i) { v0[i] = sigm(v0[i]); v1[i] = sigm(v1[i]); } }
                    u32x4 w; w.x = cvt_pk_bf16(v0[0], v0[1]); w.y = cvt_pk_bf16(v0[2], v0[3]); w.z = cvt_pk_bf16(v1[0], v1[1]); w.w = cvt_pk_bf16(v1[2], v1[3]);
                    *(u32x4*)(rowp + bj * HALF) = w; } }
    }
};

__device__ __forceinline__ void attn_item(const Params& p, LAS unsigned char* lds, int it) {
    const int tid = threadIdx.x, lane = tid & 63, wave = tid >> 6, fr = lane & 15, fq = lane >> 4;
    const int b = it >> 7, kvh = (it >> 5) & 3, qb = it & 31, t0 = b * 4096 + qb * 128;
    LAS bf16_t* Ks = (LAS bf16_t*)lds;
    LAS bf16_t* Vs = Ks + 256 * 72;
    const bf16_t* Kb = (const bf16_t*)(p.ws + OFF_K); const bf16_t* Vb = (const bf16_t*)(p.ws + OFF_V);
    const bf16_t* Q = (const bf16_t*)(p.ws + OFF_Q); bf16_t* Z = (bf16_t*)(p.ws + OFF_Z);
    const unsigned vtr_base = (unsigned)(size_t)Vs + (unsigned)((4 * fq + ((lane & 15) >> 2)) * 144 + (lane & 3) * 8);
    const int g = wave & 3, half = wave >> 2, hq = kvh * 4 + g; const float sink = p.sinks[hq] * 1.44269504f; const int dlt = fq * 4 - fr;
    u32x4 kraw[4], vraw[4];
#pragma unroll
    for (int i = 0; i < 4; ++i) { const int c = tid + 512 * i, sj = c >> 3, dc = c & 7; kraw[i] = (u32x4){0u, 0u, 0u, 0u}; vraw[i] = (u32x4){0u, 0u, 0u, 0u};
        if (qb > 0 || sj >= 128) { const size_t off = (size_t)(t0 - 128 + sj) * 256 + kvh * 64 + dc * 8; kraw[i] = *(const u32x4*)(Kb + off); vraw[i] = *(const u32x4*)(Vb + off); } }
    bf16x8 qf[2][2][2]; u32x2 zz[2][2][4];
#pragma unroll
    for (int qc = 0; qc < 2; ++qc)
#pragma unroll
        for (int qs = 0; qs < 2; ++qs) { const size_t ro = (size_t)(t0 + half * 64 + qc * 32 + qs * 16 + fr) * 1024 + hq * 64;
#pragma unroll
            for (int ks = 0; ks < 2; ++ks) qf[qc][qs][ks] = *(const bf16x8*)(Q + ro + ks * 32 + fq * 8);
#pragma unroll
            for (int dt = 0; dt < 4; ++dt) zz[qc][qs][dt] = *(const u32x2*)(Z + ro + dt * 16 + fq * 4); }
#pragma unroll
    for (int i = 0; i < 4; ++i) { const int c = tid + 512 * i, sj = c >> 3, dc = c & 7;
        *(LAS u32x4*)(Ks + sj * 72 + dc * 8) = kraw[i]; *(LAS u32x4*)(Vs + sj * 72 + dc * 8) = vraw[i]; }
    __syncthreads();
#pragma unroll
    for (int qc = 0; qc < 2; ++qc) {
        const int i0 = half * 64 + qc * 32;
        f32x4 s[10][2];
#pragma unroll
        for (int kt = 0; kt < 10; ++kt) { s[kt][0] = (f32x4){0.f, 0.f, 0.f, 0.f}; s[kt][1] = (f32x4){0.f, 0.f, 0.f, 0.f};
#pragma unroll
            for (int ks = 0; ks < 2; ++ks) { const bf16x8 kf = *(const LAS bf16x8*)(Ks + (i0 + kt * 16 + fr) * 72 + ks * 32 + fq * 8);
                s[kt][0] = mfma16(kf, qf[qc][0][ks], s[kt][0]); s[kt][1] = mfma16(kf, qf[qc][1][ks], s[kt][1]); } }
        float mx[2] = {sink, sink};
        const int lowtile = (qb == 0) ? ((128 - i0) >> 4) : 0;
#pragma unroll
        for (int kt = 0; kt < 10; ++kt) {
            if (kt < lowtile) { s[kt][0] = (f32x4){-INFINITY, -INFINITY, -INFINITY, -INFINITY}; s[kt][1] = s[kt][0]; }
#pragma unroll
            for (int qs = 0; qs < 2; ++qs)
#pragma unroll
                for (int r = 0; r < 4; ++r) { float sv = s[kt][qs][r];
                    if (kt - qs <= 0) sv = ((kt - qs) * 16 + r + dlt > 0) ? sv : -INFINITY;
                    if (kt - qs >= 8) sv = ((kt - qs) * 16 + r + dlt <= 128) ? sv : -INFINITY;
                    s[kt][qs][r] = sv; mx[qs] = fmaxf(mx[qs], sv); } }
        float inv[2];
#pragma unroll
        for (int qs = 0; qs < 2; ++qs) { mx[qs] = fmaxf(mx[qs], __shfl_xor(mx[qs], 16)); mx[qs] = fmaxf(mx[qs], __shfl_xor(mx[qs], 32)); }
        float sum[2] = {0.f, 0.f};
#pragma unroll
        for (int kt = 0; kt < 10; ++kt)
#pragma unroll
            for (int qs = 0; qs < 2; ++qs)
#pragma unroll
                for (int r = 0; r < 4; ++r) { const float pv = __builtin_amdgcn_exp2f(s[kt][qs][r] - mx[qs]); s[kt][qs][r] = pv; sum[qs] += pv; }
#pragma unroll
        for (int qs = 0; qs < 2; ++qs) { sum[qs] += __shfl_xor(sum[qs], 16); sum[qs] += __shfl_xor(sum[qs], 32); inv[qs] = __builtin_amdgcn_rcpf(sum[qs] + __builtin_amdgcn_exp2f(sink - mx[qs])); }
        f32x4 o[4][2];
#pragma unroll
        for (int dt = 0; dt < 4; ++dt) { o[dt][0] = (f32x4){0.f, 0.f, 0.f, 0.f}; o[dt][1] = (f32x4){0.f, 0.f, 0.f, 0.f}; }
#pragma unroll
        for (int kp = 0; kp < 5; ++kp) {
            bf16x8 pf[2];
#pragma unroll
            for (int qs = 0; qs < 2; ++qs) { u32x4 w; w.x = cvt_pk_bf16(s[2 * kp][qs][0], s[2 * kp][qs][1]); w.y = cvt_pk_bf16(s[2 * kp][qs][2], s[2 * kp][qs][3]);
                w.z = cvt_pk_bf16(s[2 * kp + 1][qs][0], s[2 * kp + 1][qs][1]); w.w = cvt_pk_bf16(s[2 * kp + 1][qs][2], s[2 * kp + 1][qs][3]); pf[qs] = __builtin_bit_cast(bf16x8, w); }
            u32x2 t0r[4], t1r[4];
            { const unsigned a = vtr_base + (unsigned)((i0 + kp * 32) * 144);
              asm volatile("ds_read_b64_tr_b16 %0, %8\n\tds_read_b64_tr_b16 %1, %8 offset:2304\n\tds_read_b64_tr_b16 %2, %8 offset:32\n\tds_read_b64_tr_b16 %3, %8 offset:2336\n\t"
                           "ds_read_b64_tr_b16 %4, %8 offset:64\n\tds_read_b64_tr_b16 %5, %8 offset:2368\n\tds_read_b64_tr_b16 %6, %8 offset:96\n\tds_read_b64_tr_b16 %7, %8 offset:2400\n\ts_waitcnt lgkmcnt(0)"
                           : "=&v"(t0r[0]), "=&v"(t1r[0]), "=&v"(t0r[1]), "=&v"(t1r[1]), "=&v"(t0r[2]), "=&v"(t1r[2]), "=&v"(t0r[3]), "=&v"(t1r[3]) : "v"(a) : "memory"); }
#pragma unroll
            for (int dt = 0; dt < 4; ++dt) { u32x4 aw; aw.x = t0r[dt].x; aw.y = t0r[dt].y; aw.z = t1r[dt].x; aw.w = t1r[dt].y; const bf16x8 vf = __builtin_bit_cast(bf16x8, aw);
                o[dt][0] = mfma16(vf, pf[0], o[dt][0]); o[dt][1] = mfma16(vf, pf[1], o[dt][1]); } }
#pragma unroll
        for (int qs = 0; qs < 2; ++qs)
#pragma unroll
            for (int dt = 0; dt < 4; ++dt) { bf16_t* zp = Z + (size_t)(t0 + i0 + qs * 16 + fr) * 1024 + hq * 64 + dt * 16 + fq * 4;
                const u32x2 z2 = zz[qc][qs][dt]; u32x2 w;
                w.x = cvt_pk_bf16(o[dt][qs][0] * inv[qs] * bf_lo(z2.x), o[dt][qs][1] * inv[qs] * bf_hi(z2.x));
                w.y = cvt_pk_bf16(o[dt][qs][2] * inv[qs] * bf_lo(z2.y), o[dt][qs][3] * inv[qs] * bf_hi(z2.y));
                *(u32x2*)zp = w; }
    }
    __syncthreads();
}

__device__ __forceinline__ void gates_from(float f, int lane, float& bcum) {
    float lf = fminf(f, 0.f) - log1pf(expf(-fabsf(f)));
#pragma unroll
    for (int o = 1; o < 64; o <<= 1) { const float t = __shfl_up(lf, o); if (lane >= o) lf += t; }
    bcum = lf;
}
__device__ __forceinline__ void conv_load(const bf16_t* U, int t, int pos, int bcol, u32x4 (&r)[4]) {
#pragma unroll
    for (int j = 0; j < 4; ++j) { r[j] = (u32x4){0u, 0u, 0u, 0u}; if (pos - 3 + j >= 0) r[j] = *(const u32x4*)(U + (size_t)(t - 3 + j) * 512 + bcol); }
}
__device__ __forceinline__ void conv_compute(const Params& p, const u32x4 (&r)[4], int cch, float (&o)[8]) {
    const f32x4* cb = (const f32x4*)(p.conv_b + cch); const f32x4 b0 = cb[0], b1 = cb[1];
    o[0] = b0.x; o[1] = b0.y; o[2] = b0.z; o[3] = b0.w; o[4] = b1.x; o[5] = b1.y; o[6] = b1.z; o[7] = b1.w;
#pragma unroll
    for (int j = 0; j < 4; ++j) { const u32x4 w = r[j];
        const f32x4* cw = (const f32x4*)(p.conv_w + j * 1024 + cch); const f32x4 w0 = cw[0], w1 = cw[1];
        o[0] += w0.x * bf_lo(w.x); o[1] += w0.y * bf_hi(w.x); o[2] += w0.z * bf_lo(w.y); o[3] += w0.w * bf_hi(w.y);
        o[4] += w1.x * bf_lo(w.z); o[5] += w1.y * bf_hi(w.z); o[6] += w1.z * bf_lo(w.w); o[7] += w1.w * bf_hi(w.w); }
}
__device__ __forceinline__ void vn_load(const Params& p, int ts, int hh, int hl, u32x4 (&vraw)[4]) {
    const bf16_t* MV = (const bf16_t*)(p.ws + OFF_MV);
#pragma unroll
    for (int i = 0; i < 4; ++i) { const int task = hl + 256 * i, vg = task & 15, l = task >> 4; vraw[i] = *(const u32x4*)(MV + (size_t)(ts + l) * 1024 + hh * 128 + vg * 8); }
}
__device__ __forceinline__ void vn_store(LAS bf16_t* Vn, int hl, const u32x4 (&vraw)[4]) {
#pragma unroll
    for (int i = 0; i < 4; ++i) { const int task = hl + 256 * i, vg = task & 15, l = task >> 4; *(LAS u32x4*)(Vn + l * 152 + vg * 8) = vraw[i]; }
    if (hl < 128) { const int l = hl >> 1, h2 = hl & 1; *(LAS u32x4*)(Vn + l * 152 + 128 + h2 * 8) = (u32x4){h2 ? 0u : 0x3F80u, 0u, 0u, 0u}; }
}

__device__ __forceinline__ void mlstm_pass1(const Params& p, LAS unsigned char* lds, int itp) {
    const int tid = threadIdx.x, lane = tid & 63, wave = __builtin_amdgcn_readfirstlane(tid >> 6), fr = lane & 15, fq = lane >> 4;
    const int sub = wave >> 2, hw = wave & 3, hl = tid & 255;
    const int item = 2 * itp + sub, b = item >> 9, hh = (item >> 6) & 7, c = item & 63, ts = b * 4096 + c * 64;
    LAS unsigned char* base = lds + sub * HSZ;
    LAS float* wts = (LAS float*)base;
    LAS bf16_t* Kw = (LAS bf16_t*)(base + 2048);
    LAS bf16_t* Vn = Kw + 64 * 72;
    const float* IF = (const float*)(p.ws + OFF_IF);
    const bf16_t* MK = (const bf16_t*)(p.ws + OFF_MK);
    float gf = 0.f, gi = 0.f;
    if (hw == 0) { gf = IF[(size_t)(ts + lane) * 16 + 8 + hh]; gi = IF[(size_t)(ts + lane) * 16 + hh]; }
    u32x4 kraw[2][4], vraw[4];
#pragma unroll
    for (int i = 0; i < 2; ++i) { const int task = hl + 256 * i, kg = task & 7, l = task >> 3; conv_load(MK, ts + l, c * 64 + l, hh * 64 + kg * 8, kraw[i]); }
    vn_load(p, ts, hh, hl, vraw);
    if (hw == 0) { float bc; gates_from(gf, lane, bc);
        const float gs = __shfl(bc, 63), a = gs - bc + gi, ml = wave_max(a);
        wts[lane] = expf(a - ml);
        if (lane == 0) { ((float*)(p.ws + OFF_MLOC))[item] = ml; ((float*)(p.ws + OFF_GSUM))[item] = gs; } }
    __syncthreads();
#pragma unroll
    for (int i = 0; i < 2; ++i) { const int task = hl + 256 * i, kg = task & 7, l = task >> 3; float kc[8]; conv_compute(p, kraw[i], 512 + hh * 64 + kg * 8, kc);
        const float w = wts[l]; u32x4 wk;
        wk.x = cvt_pk_bf16(silu(kc[0]) * w, silu(kc[1]) * w); wk.y = cvt_pk_bf16(silu(kc[2]) * w, silu(kc[3]) * w);
        wk.z = cvt_pk_bf16(silu(kc[4]) * w, silu(kc[5]) * w); wk.w = cvt_pk_bf16(silu(kc[6]) * w, silu(kc[7]) * w);
        *(LAS u32x4*)(Kw + l * 72 + kg * 8) = wk; }
    vn_store(Vn, hl, vraw);
    __syncthreads();
    f32x4 acc[9];
#pragma unroll
    for (int vt = 0; vt < 9; ++vt) acc[vt] = (f32x4){0.f, 0.f, 0.f, 0.f};
    const unsigned vtr1 = (unsigned)(size_t)Vn + (unsigned)((8 * fq + ((lane & 15) >> 2)) * 304 + (lane & 3) * 8);
    const unsigned ktr1 = (unsigned)(size_t)Kw + (unsigned)((8 * fq + ((lane & 15) >> 2)) * 144 + (lane & 3) * 8 + hw * 32);
#pragma unroll
    for (int ks = 0; ks < 2; ++ks) { u32x2 kt0, kt1;
        { const unsigned a = ktr1 + (unsigned)(ks * 4608);
          asm volatile("ds_read_b64_tr_b16 %0, %2\n\tds_read_b64_tr_b16 %1, %2 offset:576\n\ts_waitcnt lgkmcnt(0)" : "=&v"(kt0), "=&v"(kt1) : "v"(a) : "memory"); }
        u32x4 bw; bw.x = kt0.x; bw.y = kt0.y; bw.z = kt1.x; bw.w = kt1.y; const bf16x8 bf = __builtin_bit_cast(bf16x8, bw);
        u32x2 tr[9][2];
        { const unsigned a = vtr1 + (unsigned)(ks * 9728);
          asm volatile("ds_read_b64_tr_b16 %0, %18\n\tds_read_b64_tr_b16 %1, %18 offset:1216\n\tds_read_b64_tr_b16 %2, %18 offset:32\n\tds_read_b64_tr_b16 %3, %18 offset:1248\n\tds_read_b64_tr_b16 %4, %18 offset:64\n\tds_read_b64_tr_b16 %5, %18 offset:1280\n\tds_read_b64_tr_b16 %6, %18 offset:96\n\tds_read_b64_tr_b16 %7, %18 offset:1312\n\tds_read_b64_tr_b16 %8, %18 offset:128\n\tds_read_b64_tr_b16 %9, %18 offset:1344\n\tds_read_b64_tr_b16 %10, %18 offset:160\n\tds_read_b64_tr_b16 %11, %18 offset:1376\n\tds_read_b64_tr_b16 %12, %18 offset:192\n\tds_read_b64_tr_b16 %13, %18 offset:1408\n\tds_read_b64_tr_b16 %14, %18 offset:224\n\tds_read_b64_tr_b16 %15, %18 offset:1440\n\tds_read_b64_tr_b16 %16, %18 offset:256\n\tds_read_b64_tr_b16 %17, %18 offset:1472\n\ts_waitcnt lgkmcnt(0)" : "=&v"(tr[0][0]), "=&v"(tr[0][1]), "=&v"(tr[1][0]), "=&v"(tr[1][1]), "=&v"(tr[2][0]), "=&v"(tr[2][1]), "=&v"(tr[3][0]), "=&v"(tr[3][1]), "=&v"(tr[4][0]), "=&v"(tr[4][1]), "=&v"(tr[5][0]), "=&v"(tr[5][1]), "=&v"(tr[6][0]), "=&v"(tr[6][1]), "=&v"(tr[7][0]), "=&v"(tr[7][1]), "=&v"(tr[8][0]), "=&v"(tr[8][1]) : "v"(a) : "memory"); }
#pragma unroll
        for (int vt = 0; vt < 9; ++vt) { u32x4 aw; aw.x = tr[vt][0].x; aw.y = tr[vt][0].y; aw.z = tr[vt][1].x; aw.w = tr[vt][1].y; acc[vt] = mfma16(__builtin_bit_cast(bf16x8, aw), bf, acc[vt]); } }
    bf16_t* cst = (bf16_t*)((unsigned char*)p.out + OUT_CST) + (size_t)item * 9216;
#pragma unroll
    for (int vt = 0; vt < 9; ++vt)
#pragma unroll
        for (int r = 0; r < 4; ++r) cst[(vt * 16 + fq * 4 + r) * 64 + hw * 16 + fr] = f2bf(acc[vt][r]);
    __syncthreads();
}


__device__ __forceinline__ void mlstm_scan(const Params& p, int G) {
    const float* mloc = (const float*)(p.ws + OFF_MLOC); const float* gsum = (const float*)(p.ws + OFF_GSUM); float* mprev = (float*)(p.ws + OFF_MPREV);
    bf16_t* cst = (bf16_t*)((unsigned char*)p.out + OUT_CST);
    for (int task = blockIdx.x * 512 + threadIdx.x; task < 32 * 2304; task += G * 512) {
        const int bh = task / 2304, e = task % 2304;
        float s0 = 0.f, s1 = 0.f, s2 = 0.f, s3 = 0.f, m = -1e30f;
        u32x2* ptr = (u32x2*)(cst + (size_t)bh * 64 * 9216 + e * 4);
        for (int c0 = 0; c0 < 64; c0 += 16) { u32x2 clv[16]; float glv[16], mlv[16];
#pragma unroll
            for (int i = 0; i < 16; ++i) { clv[i] = ptr[(size_t)i * (9216 / 4)]; glv[i] = gsum[bh * 64 + c0 + i]; mlv[i] = mloc[bh * 64 + c0 + i]; }
#pragma unroll
            for (int i = 0; i < 16; ++i) { const float gl = glv[i], ml = mlv[i]; const u32x2 cl = clv[i];
                u32x2 w; w.x = cvt_pk_bf16(s0, s1); w.y = cvt_pk_bf16(s2, s3); ptr[(size_t)i * (9216 / 4)] = w;
                if (e == 0) mprev[bh * 64 + c0 + i] = m;
                const float mn = fmaxf(gl + m, ml), sp = __expf(gl + m - mn), sl = __expf(ml - mn);
                s0 = sp * s0 + sl * bf_lo(cl.x); s1 = sp * s1 + sl * bf_hi(cl.x); s2 = sp * s2 + sl * bf_lo(cl.y); s3 = sp * s3 + sl * bf_hi(cl.y);
                m = mn; }
            ptr += 16 * (9216 / 4); }
    }
}

__device__ __forceinline__ void mlstm_pass3(const Params& p, LAS unsigned char* lds, int itp) {
    const int tid = threadIdx.x, lane = tid & 63, wave = __builtin_amdgcn_readfirstlane(tid >> 6), fr = lane & 15, fq = lane >> 4;
    const int sub = wave >> 2, hw = wave & 3, hl = tid & 255;
    const int item = 2 * itp + sub, b = item >> 9, hh = (item >> 6) & 7, c = item & 63, ts = b * 4096 + c * 64;
    LAS unsigned char* base = lds + sub * HSZ;
    LAS float* fb = (LAS float*)base; LAS float* fu = fb + 64; LAS float* fM = fb + 128; LAS float* fI = fb + 192;
    LAS bf16_t* Ks = (LAS bf16_t*)(base + 2048);
    LAS bf16_t* Vn = Ks + 64 * 72;
    LAS bf16_t* Qs = Vn + 64 * 152;
    const float* IF = (const float*)(p.ws + OFF_IF);
    const bf16_t* MQ = (const bf16_t*)(p.ws + OFF_MQ); const bf16_t* MK = (const bf16_t*)(p.ws + OFF_MK);
    bf16_t* OG = (bf16_t*)(p.ws + OFF_OG);
    const bf16_t* cst = (const bf16_t*)((unsigned char*)p.out + OUT_CST) + (size_t)item * 9216;
    float gf = 0.f, gi = 0.f, mp = 0.f;
    if (hw == 0) { gf = IF[(size_t)(ts + lane) * 16 + 8 + hh]; gi = IF[(size_t)(ts + lane) * 16 + hh]; mp = ((const float*)(p.ws + OFF_MPREV))[item]; }
    u32x4 qraw[2][4], kraw[2][4], vraw[4];
#pragma unroll
    for (int i = 0; i < 2; ++i) { const int task = hl + 256 * i, kg = task & 7, l = task >> 3;
        conv_load(MQ, ts + l, c * 64 + l, hh * 64 + kg * 8, qraw[i]); conv_load(MK, ts + l, c * 64 + l, hh * 64 + kg * 8, kraw[i]); }
    vn_load(p, ts, hh, hl, vraw);
    if (hw == 0) { float bc; gates_from(gf, lane, bc);
        const float u = gi - bc; float pm = u;
#pragma unroll
        for (int o = 1; o < 64; o <<= 1) { const float t = __shfl_up(pm, o); if (lane >= o) pm = fmaxf(pm, t); }
        const float M = fmaxf(mp, pm);
        fb[lane] = bc; fu[lane] = u * 1.44269504f; fM[lane] = M; fI[lane] = expf(mp - M); }
#pragma unroll
    for (int i = 0; i < 2; ++i) { const int task = hl + 256 * i, kg = task & 7, l = task >> 3; float qc[8], kc[8];
        conv_compute(p, qraw[i], hh * 64 + kg * 8, qc); conv_compute(p, kraw[i], 512 + hh * 64 + kg * 8, kc);
        u32x4 wq, wk;
        wq.x = cvt_pk_bf16(0.125f * silu(qc[0]), 0.125f * silu(qc[1])); wq.y = cvt_pk_bf16(0.125f * silu(qc[2]), 0.125f * silu(qc[3]));
        wq.z = cvt_pk_bf16(0.125f * silu(qc[4]), 0.125f * silu(qc[5])); wq.w = cvt_pk_bf16(0.125f * silu(qc[6]), 0.125f * silu(qc[7]));
        wk.x = cvt_pk_bf16(silu(kc[0]), silu(kc[1])); wk.y = cvt_pk_bf16(silu(kc[2]), silu(kc[3]));
        wk.z = cvt_pk_bf16(silu(kc[4]), silu(kc[5])); wk.w = cvt_pk_bf16(silu(kc[6]), silu(kc[7]));
        *(LAS u32x4*)(Qs + l * 72 + kg * 8) = wq; *(LAS u32x4*)(Ks + l * 72 + kg * 8) = wk; }
    vn_store(Vn, hl, vraw);
    __syncthreads();
    const int l = hw * 16 + fr;
    const unsigned vtr3 = (unsigned)(size_t)Vn + (unsigned)((4 * fq + ((lane & 15) >> 2)) * 304 + (lane & 3) * 8);
    bf16x8 qf[2];
#pragma unroll
    for (int ks = 0; ks < 2; ++ks) qf[ks] = *(const LAS bf16x8*)(Qs + l * 72 + ks * 32 + fq * 8);
    f32x4 sT[4];
#pragma unroll
    for (int st = 0; st < 4; ++st) { sT[st] = (f32x4){0.f, 0.f, 0.f, 0.f};
#pragma unroll
        for (int ks = 0; ks < 2; ++ks) { const bf16x8 kf = *(const LAS bf16x8*)(Ks + (st * 16 + fr) * 72 + ks * 32 + fq * 8); sT[st] = mfma16(kf, qf[ks], sT[st]); } }
    const float Ml = fM[l], Ml2 = Ml * 1.44269504f;
#pragma unroll
    for (int st = 0; st < 4; ++st) { const f32x4 uv = *(const LAS f32x4*)(fu + st * 16 + fq * 4);
#pragma unroll
        for (int r = 0; r < 4; ++r) { const int s = st * 16 + fq * 4 + r; sT[st][r] = (s <= l) ? sT[st][r] * __builtin_amdgcn_exp2f(uv[r] - Ml2) : 0.f; } }
    f32x4 ai[9], ae[9];
#pragma unroll
    for (int vt = 0; vt < 9; ++vt) { ai[vt] = (f32x4){0.f, 0.f, 0.f, 0.f}; ae[vt] = (f32x4){0.f, 0.f, 0.f, 0.f}; }
#pragma unroll
    for (int kk = 0; kk < 2; ++kk) {
        u32x4 w; w.x = cvt_pk_bf16(sT[2 * kk][0], sT[2 * kk][1]); w.y = cvt_pk_bf16(sT[2 * kk][2], sT[2 * kk][3]);
        w.z = cvt_pk_bf16(sT[2 * kk + 1][0], sT[2 * kk + 1][1]); w.w = cvt_pk_bf16(sT[2 * kk + 1][2], sT[2 * kk + 1][3]);
        const bf16x8 pf = __builtin_bit_cast(bf16x8, w);
        u32x2 tr[9][2];
        { const unsigned a = vtr3 + (unsigned)(kk * 9728);
          asm volatile("ds_read_b64_tr_b16 %0, %18\n\tds_read_b64_tr_b16 %1, %18 offset:4864\n\tds_read_b64_tr_b16 %2, %18 offset:32\n\tds_read_b64_tr_b16 %3, %18 offset:4896\n\tds_read_b64_tr_b16 %4, %18 offset:64\n\tds_read_b64_tr_b16 %5, %18 offset:4928\n\tds_read_b64_tr_b16 %6, %18 offset:96\n\tds_read_b64_tr_b16 %7, %18 offset:4960\n\tds_read_b64_tr_b16 %8, %18 offset:128\n\tds_read_b64_tr_b16 %9, %18 offset:4992\n\tds_read_b64_tr_b16 %10, %18 offset:160\n\tds_read_b64_tr_b16 %11, %18 offset:5024\n\tds_read_b64_tr_b16 %12, %18 offset:192\n\tds_read_b64_tr_b16 %13, %18 offset:5056\n\tds_read_b64_tr_b16 %14, %18 offset:224\n\tds_read_b64_tr_b16 %15, %18 offset:5088\n\tds_read_b64_tr_b16 %16, %18 offset:256\n\tds_read_b64_tr_b16 %17, %18 offset:5120\n\ts_waitcnt lgkmcnt(0)" : "=&v"(tr[0][0]), "=&v"(tr[0][1]), "=&v"(tr[1][0]), "=&v"(tr[1][1]), "=&v"(tr[2][0]), "=&v"(tr[2][1]), "=&v"(tr[3][0]), "=&v"(tr[3][1]), "=&v"(tr[4][0]), "=&v"(tr[4][1]), "=&v"(tr[5][0]), "=&v"(tr[5][1]), "=&v"(tr[6][0]), "=&v"(tr[6][1]), "=&v"(tr[7][0]), "=&v"(tr[7][1]), "=&v"(tr[8][0]), "=&v"(tr[8][1]) : "v"(a) : "memory"); }
#pragma unroll
        for (int vt = 0; vt < 9; ++vt) { u32x4 aw; aw.x = tr[vt][0].x; aw.y = tr[vt][0].y; aw.z = tr[vt][1].x; aw.w = tr[vt][1].y;
            ai[vt] = mfma16(__builtin_bit_cast(bf16x8, aw), pf, ai[vt]);
            const bf16x8 cf = *(const bf16x8*)(cst + (vt * 16 + fr) * 64 + kk * 32 + fq * 8);
            ae[vt] = mfma16(cf, qf[kk], ae[vt]); } }
    const float inter = fI[l];
#pragma unroll
    for (int vt = 0; vt < 9; ++vt) ai[vt] = ai[vt] + inter * ae[vt];
    const float den = __shfl(ai[8][0], fr);
    const float rD = 1.f / fmaxf(fabsf(den), expf(-(fb[l] + Ml)));
    float ss = 0.f;
#pragma unroll
    for (int vt = 0; vt < 8; ++vt) { ai[vt] = ai[vt] * rD; ss += (ai[vt][0] * ai[vt][0] + ai[vt][1] * ai[vt][1]) + (ai[vt][2] * ai[vt][2] + ai[vt][3] * ai[vt][3]); }
    ss += __shfl_xor(ss, 16); ss += __shfl_xor(ss, 32);
    const float rs = rsqrtf(ss * (1.f / 128.f) + 1e-6f);
#pragma unroll
    for (int vt = 0; vt < 8; ++vt) { const int v0 = vt * 16 + fq * 4; bf16_t* op = OG + (size_t)(ts + l) * 1024 + hh * 128 + v0;
        const u32x2 og = *(const u32x2*)op; const f32x4 nw = *(const f32x4*)(p.mnorm_w + hh * 128 + v0);
        u32x2 w; w.x = cvt_pk_bf16(bf_lo(og.x) * ai[vt][0] * rs * nw.x, bf_hi(og.x) * ai[vt][1] * rs * nw.y);
        w.y = cvt_pk_bf16(bf_lo(og.y) * ai[vt][2] * rs * nw.z, bf_hi(og.y) * ai[vt][3] * rs * nw.w);
        *(u32x2*)op = w; }
    __syncthreads();
}


struct PairOrder {
    StaticOrder so;
    __device__ bool next(int i, Unit& u) const { if (!so.next(i >> 1, u)) return false; if (i & 1) { u.pm += 64; u.pn += 4; } return true; }
    __device__ __forceinline__ void a_ready(const Unit&) const {}
    __device__ __forceinline__ void done(const Unit&) const {}
};
struct EpiMerge {
    static constexpr bool PERM = true, AFTER_DRAIN = false;
    const bf16_t *GA, *GM; bf16_t* Mg;
    __device__ __forceinline__ bool keep(const Unit& u) const { return u.pn < 4; }
    __device__ __forceinline__ void operator()(f32x4 (&acc)[2][2][4][2], const Unit& u, int ui, int wr, int wc, int fr, int fq) const {
        const bool first = u.pn < 4; const int pm = first ? u.pm : u.pm - 64, pn = first ? u.pn : u.pn - 4;
        const int row0 = pm * BM + wr * 64 + fr, col0 = pn * BM + wc * 32 + 8 * fq;
#pragma unroll
        for (int ai = 0; ai < 2; ++ai)
#pragma unroll
            for (int m = 0; m < 4; ++m)
#pragma unroll
                for (int bj = 0; bj < 2; ++bj) { const size_t idx = (size_t)(row0 + ai * HALF + m * 16) * 1024 + col0 + bj * HALF;
                    const u32x4 gm = *(const u32x4*)((first ? GA : GM) + idx);
                    float gmf[8] = {bf_lo(gm.x), bf_hi(gm.x), bf_lo(gm.y), bf_hi(gm.y), bf_lo(gm.z), bf_hi(gm.z), bf_lo(gm.w), bf_hi(gm.w)};
                    if (first) {
#pragma unroll
                        for (int i = 0; i < 4; ++i) { acc[ai][bj][m][0][i] *= gmf[i]; acc[ai][bj][m][1][i] *= gmf[4 + i]; } }
                    else { u32x4 w;
                        w.x = cvt_pk_bf16(acc[ai][bj][m][0][0] * gmf[0], acc[ai][bj][m][0][1] * gmf[1]); w.y = cvt_pk_bf16(acc[ai][bj][m][0][2] * gmf[2], acc[ai][bj][m][0][3] * gmf[3]);
                        w.z = cvt_pk_bf16(acc[ai][bj][m][1][0] * gmf[4], acc[ai][bj][m][1][1] * gmf[5]); w.w = cvt_pk_bf16(acc[ai][bj][m][1][2] * gmf[6], acc[ai][bj][m][1][3] * gmf[7]);
                        *(u32x4*)(Mg + idx) = w; } }
    }
};
struct EpiOut {
    static constexpr bool PERM = false, AFTER_DRAIN = false;
    const float* x; float* out;
    __device__ __forceinline__ bool keep(const Unit&) const { return false; }
    __device__ __forceinline__ void operator()(const f32x4 (&acc)[2][2][4][2], const Unit& u, int ui, int wr, int wc, int fr, int fq) const {
        const int row0 = u.pm * BM + wr * 64 + fr, col0 = u.pn * BM + wc * 32 + 4 * fq;
#pragma unroll
        for (int ai = 0; ai < 2; ++ai)
#pragma unroll
            for (int m = 0; m < 4; ++m) { const size_t ro = (size_t)(row0 + ai * HALF + m * 16) * 1024 + col0;
#pragma unroll
                for (int bj = 0; bj < 2; ++bj)
#pragma unroll
                    for (int n = 0; n < 2; ++n) { const f32x4 xv = *(const f32x4*)(x + ro + bj * HALF + n * 16); *(f32x4*)(out + ro + bj * HALF + n * 16) = acc[ai][bj][m][n] + xv; } }
    }
};

struct EpiOutNorm {
    static constexpr bool PERM = false, AFTER_DRAIN = true;
    const float* x; float* out; const float* fw; float* rowss; unsigned* pcnt;
    __device__ __forceinline__ bool keep(const Unit&) const { return false; }
    __device__ __forceinline__ void fused(f32x4 (&acc)[2][2][4][2], const Unit& u, int wr, int wc, int fr, int fq, PG8_LAS unsigned char*, int wid, int lane) const {
        const int row0 = u.pm * BM + wr * 64 + fr, col0 = u.pn * BM + wc * 32 + 4 * fq;
        float dummy = 0.f;
#pragma unroll
        for (int ai = 0; ai < 2; ++ai) { f32x4 xv[4][2][2];
#pragma unroll
            for (int m = 0; m < 4; ++m) { const size_t ro = (size_t)(row0 + ai * HALF + m * 16) * 1024 + col0;
#pragma unroll
                for (int bj = 0; bj < 2; ++bj)
#pragma unroll
                    for (int n = 0; n < 2; ++n) xv[m][bj][n] = *(const f32x4*)(x + ro + bj * HALF + n * 16); }
#pragma unroll
            for (int m = 0; m < 4; ++m) { float ss = 0.f;
#pragma unroll
                for (int bj = 0; bj < 2; ++bj)
#pragma unroll
                    for (int n = 0; n < 2; ++n) { const f32x4 v = acc[ai][bj][m][n] + xv[m][bj][n]; acc[ai][bj][m][n] = v; ss += (v.x * v.x + v.y * v.y) + (v.z * v.z + v.w * v.w); }
                ss += __shfl_xor(ss, 16); ss += __shfl_xor(ss, 32);
                if (fq == 0) dummy += __hip_atomic_fetch_add(rowss + row0 + ai * HALF + m * 16, ss, __ATOMIC_RELAXED, __HIP_MEMORY_SCOPE_AGENT); }
            __builtin_amdgcn_sched_barrier(0); }
        asm volatile("s_waitcnt vmcnt(0)" :: "v"(dummy) : "memory");
        __syncthreads();
        if (wid == 0 && lane == 0) { unsigned* cnt = pcnt + 64 * u.pm;
            (void)__hip_atomic_fetch_add(cnt, 1u, __ATOMIC_RELAXED, __HIP_MEMORY_SCOPE_AGENT);
            unsigned sp = 0;
            while (__hip_atomic_load(cnt, __ATOMIC_RELAXED, __HIP_MEMORY_SCOPE_AGENT) < 4u) { __builtin_amdgcn_s_sleep(8); if (++sp > (1u << 17)) break; } }
        __syncthreads();
        f32x4 wv[2][2];
#pragma unroll
        for (int bj = 0; bj < 2; ++bj)
#pragma unroll
            for (int n = 0; n < 2; ++n) wv[bj][n] = *(const f32x4*)(fw + col0 + bj * HALF + n * 16);
        float tot[2][4];
#pragma unroll
        for (int ai = 0; ai < 2; ++ai)
#pragma unroll
            for (int m = 0; m < 4; ++m) { tot[ai][m] = 0.f; if (fq == 0) tot[ai][m] = __hip_atomic_fetch_add(rowss + row0 + ai * HALF + m * 16, 0.0f, __ATOMIC_RELAXED, __HIP_MEMORY_SCOPE_AGENT); }
#pragma unroll
        for (int ai = 0; ai < 2; ++ai)
#pragma unroll
            for (int m = 0; m < 4; ++m) { const int row = row0 + ai * HALF + m * 16;
                const float rstd = rsqrtf(__shfl(tot[ai][m], fr) * (1.f / 1024.f) + 1e-6f);
                const size_t ro = (size_t)row * 1024 + col0;
#pragma unroll
                for (int bj = 0; bj < 2; ++bj)
#pragma unroll
                    for (int n = 0; n < 2; ++n) *(f32x4*)(out + ro + bj * HALF + n * 16) = acc[ai][bj][m][n] * rstd * wv[bj][n]; }
    }
};


#define XB_TMO      128
#define XB_XCNT(j)  (256  + 64 * (j))
#define XB_XSUB(j)  (1280 + 64 * (j))
#define XB_XGEN(j)  (2304 + 64 * (j))
#define XB_TOP      3328
#define XB_TOPGEN   3392
#define XCD_BAR_WORDS 3456
#define XB_SPIN_CAP (1u << 18)

__device__ __forceinline__ unsigned xb_ld(unsigned* p)              { return __hip_atomic_load(p, __ATOMIC_RELAXED, __HIP_MEMORY_SCOPE_AGENT); }
__device__ __forceinline__ unsigned xb_add(unsigned* p, unsigned v) { return __hip_atomic_fetch_add(p, v, __ATOMIC_RELAXED, __HIP_MEMORY_SCOPE_AGENT); }
__device__ __forceinline__ unsigned xb_xcc_id() { return (unsigned)__builtin_amdgcn_s_getreg((3 << 11) | 20) & 0xFu; }
#define XB_SPIN(cond, bar) do { unsigned _sp = 0; while (cond) { __builtin_amdgcn_s_sleep(1); \
    if ((++_sp & 255u) == 0u) { if (xb_ld(&(bar)[XB_TMO])) break; if (_sp > XB_SPIN_CAP) { atomicAdd(&(bar)[XB_TMO], 1u); break; } } } } while (0)

struct XcdBarrier {
    unsigned* bar; unsigned x;
    volatile LAS unsigned* st;
};

__device__ __forceinline__ XcdBarrier xcd_barrier_post(unsigned* bar, volatile LAS unsigned* st) {
    XcdBarrier b; b.bar = bar; b.x = xb_xcc_id(); b.st = st;
    if (threadIdx.x == 0) (void)xb_add(&bar[XB_XCNT(b.x)], 1u);
    return b;
}
__device__ __forceinline__ void xcd_barrier_complete(unsigned* bar, unsigned x, unsigned& nloc, unsigned& nx) {
    const unsigned G = gridDim.x * gridDim.y * gridDim.z;
    unsigned sum, cnt, mine, sp = 0u;
    for (;;) {
        sum = 0u; cnt = 0u; mine = 0u;
#pragma unroll
        for (unsigned j = 0; j < 16; ++j) { const unsigned c = xb_ld(&bar[XB_XCNT(j)]); sum += c; cnt += (c > 0u) ? 1u : 0u; mine = (j == x) ? c : mine; }
        if (sum == G) break;
        __builtin_amdgcn_s_sleep(1);
        if ((++sp & 255u) == 0u) { if (xb_ld(&bar[XB_TMO])) break; if (sp > XB_SPIN_CAP) { atomicAdd(&bar[XB_TMO], 1u); break; } }
    }
    nloc = mine > 0u ? mine : 1u; nx = cnt > 0u ? cnt : 1u;
}

__device__ __forceinline__ void xcd_barrier(const XcdBarrier& b) {
    asm volatile("s_waitcnt vmcnt(0)" ::: "memory");
    __syncthreads();
    if (threadIdx.x == 0) {
        unsigned* bar = b.bar;
        __builtin_amdgcn_s_waitcnt(0);
        unsigned nloc = b.st[0], nx = b.st[1];
        if (nloc == 0u) { xcd_barrier_complete(bar, b.x, nloc, nx); b.st[0] = nloc; b.st[1] = nx; }
        const unsigned old = xb_add(&bar[XB_XSUB(b.x)], 1u);
        const unsigned gen = old / nloc;
        if (old + 1u == (gen + 1u) * nloc) {
            __builtin_amdgcn_fence(__ATOMIC_RELEASE, "agent");
            asm volatile("s_waitcnt vmcnt(0)" ::: "memory");
            const unsigned og = xb_add(&bar[XB_TOP], 1u);
            const unsigned tg = og / nx;
            if (og + 1u == (tg + 1u) * nx) xb_add(&bar[XB_TOPGEN], 1u);
            else XB_SPIN(xb_ld(&bar[XB_TOPGEN]) == tg, bar);
            __builtin_amdgcn_fence(__ATOMIC_ACQUIRE, "agent");
            xb_add(&bar[XB_XGEN(b.x)], 1u);
            asm volatile("s_waitcnt vmcnt(0)" ::: "memory");
        } else {
            XB_SPIN(xb_ld(&bar[XB_XGEN(b.x)]) == gen, bar);
            __builtin_amdgcn_fence(__ATOMIC_ACQUIRE, "agent");
            asm volatile("s_waitcnt vmcnt(0)" ::: "memory");
        }
    }
    __syncthreads();
}

__global__ void __launch_bounds__(512, 2) mega(Params p) {
    extern __shared__ __attribute__((aligned(16))) unsigned char shm[];
    LAS unsigned char* lds = (LAS unsigned char*)shm;
    const int G = gridDim.x;
    volatile LAS unsigned* xbw = (volatile LAS unsigned*)(lds + 131072);
    if (threadIdx.x < 4) xbw[threadIdx.x] = 0u;
    __syncthreads();
    const XcdBarrier xb = xcd_barrier_post((unsigned*)(p.ws + OFF_BAR), xbw);
#ifndef PROBE_MASK
#define PROBE_MASK 0
#endif
    unsigned long long pt0 = PROBE_MASK ? wall_clock64() : 0ull;
#define PHASE(n) if (p.ph_lo <= (n) && (n) < p.ph_hi)
#define SEAM(n) if (PROBE_MASK) { if ((PROBE_MASK >> ((n) - 1)) & 1) { __syncthreads(); const unsigned long long pt1 = wall_clock64(); while (wall_clock64() - pt1 < pt1 - pt0) __builtin_amdgcn_s_sleep(8); } } \
    if (p.ph_lo < (n) && (n) < p.ph_hi) xcd_barrier(xb); if (PROBE_MASK) pt0 = wall_clock64();
    PHASE(0) phase0(p, lds, G);
    SEAM(1)
    PHASE(1) {
        Gemm g; g.A = (const bf16_t*)((unsigned char*)p.out + OUT_H); g.Bt = (const bf16_t*)((unsigned char*)p.out + OUT_WTIN); g.M = T_TOK; g.N = NPT; g.K = 1024;
        StaticOrder S; S.init(T_TOK, NPT, G, blockIdx.x);
        LAS float* biasl = (LAS float*)(lds + 131072 + 16);
        { const float* biasp = (const float*)(p.ws + OFF_BIASP); Unit u;
          for (int i = 0; i < BIAS_UNITS && S.next(i, u); ++i) if (threadIdx.x < 256) biasl[i * 256 + threadIdx.x] = biasp[u.pn * 256 + threadIdx.x];
          __syncthreads(); }
        Epi1 E; E.ws = p.ws; E.biasl = biasl;
        gemm_phase<Epi1, StaticOrder, true, true>(lds, g, S, E);
    }
    SEAM(2)
    PHASE(2) {
        for (int it = blockIdx.x; it < 512; it += G) attn_item(p, lds, it);
        for (int itp = blockIdx.x; itp < 1024; itp += G) mlstm_pass1(p, lds, itp);
    }
    SEAM(3)
    PHASE(3) mlstm_scan(p, G);
    SEAM(4)
    PHASE(4) { for (int itp = blockIdx.x; itp < 1024; itp += G) mlstm_pass3(p, lds, itp); }
    SEAM(5)
    PHASE(5) {
        Gemm g; g.A = (const bf16_t*)(p.ws + OFF_Z); g.Bt = (const bf16_t*)(p.ws + OFF_WAT); g.M = T_TOK; g.N = 1024; g.K = 1024;
        PairOrder S; S.so.init(T_TOK, 1024, G, blockIdx.x);
        EpiMerge E; E.GA = (const bf16_t*)(p.ws + OFF_GA); E.GM = (const bf16_t*)(p.ws + OFF_GM); E.Mg = (bf16_t*)(p.ws + OFF_Q);
        gemm_phase<EpiMerge, PairOrder, true, true>(lds, g, S, E);
    }
    SEAM(6)
    PHASE(6) {
        Gemm g; g.A = (const bf16_t*)(p.ws + OFF_Q); g.Bt = (const bf16_t*)(p.ws + OFF_WOT); g.M = T_TOK; g.N = 1024; g.K = 1024;
        StaticOrder S; S.init(T_TOK, 1024, G, blockIdx.x);
        if (G == 256) { EpiOutNorm E; E.x = p.x; E.out = p.out; E.fw = p.fnorm_w; E.rowss = (float*)(p.ws + OFF_ROWSS); E.pcnt = (unsigned*)(p.ws + OFF_PCNT);
            gemm_phase<EpiOutNorm, StaticOrder, false, true>(lds, g, S, E); }
        else { EpiOut E; E.x = p.x; E.out = p.out; gemm_phase<EpiOut, StaticOrder, true, true>(lds, g, S, E); }
    }
    if (G != 256) {
    SEAM(7)
    PHASE(7) {
        const int lane = threadIdx.x & 63, gw = blockIdx.x * 8 + (threadIdx.x >> 6);
        f32x4 nwv[4];
#pragma unroll
        for (int j = 0; j < 4; ++j) nwv[j] = ((const f32x4*)p.fnorm_w)[64 * j + lane];
        for (int row = gw; row < T_TOK; row += G * 32) {
            f32x4 v[4][4];
#pragma unroll
            for (int i = 0; i < 4; ++i) { const int r = row + i * G * 8;
                if (r < T_TOK) {
#pragma unroll
                    for (int j = 0; j < 4; ++j) v[i][j] = ((const f32x4*)(p.out + (size_t)r * 1024) + lane)[64 * j]; } }
#pragma unroll
            for (int i = 0; i < 4; ++i) { const int r = row + i * G * 8;
                if (r < T_TOK) { float ss = 0.f;
#pragma unroll
                    for (int j = 0; j < 4; ++j) ss += (v[i][j].x * v[i][j].x + v[i][j].y * v[i][j].y) + (v[i][j].z * v[i][j].z + v[i][j].w * v[i][j].w);
                    ss = wave_sum(ss);
                    const float rstd = rsqrtf(ss * (1.f / 1024.f) + 1e-6f);
#pragma unroll
                    for (int j = 0; j < 4; ++j) ((f32x4*)(p.out + (size_t)r * 1024) + lane)[64 * j] = v[i][j] * rstd * nwv[j]; } }
        }
    }
    }
}

extern "C" void kernel_launch(void* const* d_in, const int* in_sizes, int n_in, void* d_out, int out_size, void* d_ws, size_t ws_size, hipStream_t stream) {
    static int grid = 0;
    if (grid == 0) {
        if (n_in != 12 || out_size != T_TOK * 1024 || ws_size < WS_END) { fprintf(stderr, "kernel_launch: unexpected shapes (n_in %d out %d ws %zu)\n", n_in, out_size, ws_size); grid = -1; return; }
        int dev = 0, cus = 0, per_cu = 0;
        (void)hipGetDevice(&dev); (void)hipDeviceGetAttribute(&cus, hipDeviceAttributeMultiprocessorCount, dev);
        if (hipFuncSetAttribute((const void*)mega, hipFuncAttributeMaxDynamicSharedMemorySize, LDS_BYTES) != hipSuccess) { fprintf(stderr, "kernel_launch: hipFuncSetAttribute failed\n"); grid = -1; return; }
        if (hipOccupancyMaxActiveBlocksPerMultiprocessor(&per_cu, (const void*)mega, 512, LDS_BYTES) != hipSuccess || per_cu < 1) { fprintf(stderr, "kernel_launch: occupancy query failed (%d)\n", per_cu); grid = -1; return; }
        grid = cus * per_cu;
    }
    if (grid < 0) return;
    if (hipMemsetAsync((char*)d_ws + OFF_BAR, 0, (size_t)(OFF_ROWSS + 65536 - OFF_BAR), stream) != hipSuccess) { fprintf(stderr, "kernel_launch: memset failed\n"); return; }
    Params p{};
    p.x = (const float*)d_in[0]; p.norm_w = (const float*)d_in[1]; p.w_in = (const float*)d_in[2]; p.b_in = (const float*)d_in[3]; p.sinks = (const float*)d_in[4];
    p.conv_w = (const float*)d_in[5]; p.conv_b = (const float*)d_in[6]; p.mnorm_w = (const float*)d_in[7]; p.w_ba = (const float*)d_in[8]; p.w_bm = (const float*)d_in[9];
    p.w_out = (const float*)d_in[10]; p.fnorm_w = (const float*)d_in[11];
    p.out = (float*)d_out; p.ws = (unsigned char*)d_ws; p.ph_lo = 0; p.ph_hi = 8;
    void* args[] = {&p};
    hipError_t e = hipLaunchCooperativeKernel((const void*)mega, dim3(grid), dim3(512), args, LDS_BYTES, stream);
    if (e != hipSuccess) fprintf(stderr, "kernel_launch: cooperative launch failed: %s (grid %d)\n", hipGetErrorString(e), grid);
}
```

```cpp
#include <hip/hip_runtime.h>
#include <cstdio>
#include <cmath>
namespace pg8 {
#define PG8_LAS __attribute__((address_space(3)))
typedef unsigned short bf16_t;
typedef short bf16x8 __attribute__((ext_vector_type(8)));
typedef float f32x4 __attribute__((ext_vector_type(4)));
typedef unsigned u32x4 __attribute__((ext_vector_type(4)));
constexpr int BM = 256, BK = 64, HALF = 128, HTB = HALF * BK * 2  , STAGE_BYTES = 8 * HTB, NXCD = 8, WGM = 8;

__host__ __device__ __forceinline__ int lds_byte(int r, int c) { const int st = (r >> 4) * 2 + (c >> 5), rr = r & 15, cc = c & 31, ob = rr * 64 + cc * 2; return st * 1024 + (ob ^ (((ob >> 9) & 1) << 5)); }
__host__ __device__ __forceinline__ void stage_rc(int b, int& R, int& C) { const int st = b / 1024, sb = b % 1024, swz = sb ^ (((sb >> 9) & 1) << 5); R = (st >> 1) * 16 + swz / 64; C = (st & 1) * 32 + (swz % 64) / 2; }
__host__ __device__ __forceinline__ int perm32(int rho) { const int n = rho >> 4, i = rho & 15; return 8 * (i >> 2) + 4 * n + (i & 3); }

struct Unit { int pm, pn; };
struct Gemm { const bf16_t* A; const bf16_t* Bt; int M, N, K; };

struct StaticOrder {
    int nM, nN, nwg, G, c;
    __host__ __device__ void init(int M, int N, int G_, int c_) { nM = M / BM; nN = N / BM; nwg = nM * nN; G = G_; c = c_; }
    __host__ __device__ bool next(int i, Unit& u) const {
        const long L = (long)i * G + c; if (L >= nwg) return false;
        int wgid = (int)L; { const int q = nwg / NXCD, r = nwg % NXCD, xcd = wgid % NXCD, off = wgid / NXCD; wgid = (xcd < r ? xcd * (q + 1) : r * (q + 1) + (xcd - r) * q) + off; }
        const int nig = WGM * nN, gid = wgid / nig, fm = gid * WGM, gsz = (nM - fm) < WGM ? (nM - fm) : WGM;
        u.pm = fm + ((wgid % nig) % gsz); u.pn = (wgid % nig) / gsz; return true;
    }
    __device__ __forceinline__ void a_ready(const Unit&) const {}
    __device__ __forceinline__ void done(const Unit&) const {}
};
__device__ __forceinline__ unsigned cvt_pk_bf16(float lo, float hi) { unsigned r; asm volatile("v_cvt_pk_bf16_f32 %0, %1, %2" : "=v"(r) : "v"(lo), "v"(hi)); return r; }
template <class Epi, class Sched, bool ALIGN_EPI = false, bool SP2 = false>
__device__ __forceinline__ void gemm_phase(PG8_LAS unsigned char* lds, const Gemm g, const Sched& S, const Epi& E) {
    const int tid = threadIdx.x, wid = __builtin_amdgcn_readfirstlane(tid >> 6), lane = tid & 63, wr = wid >> 2, wc = wid & 3, fr = lane & 15, fq = lane >> 4;
    const int K = g.K, nt = K / BK;
    unsigned voffA[2], voffB[2];
#pragma unroll
    for (int i = 0; i < 2; ++i) { int R, C; stage_rc(tid * 16 + i * 8192, R, C); const int Rb = Epi::PERM ? ((R & ~31) + perm32(R & 31)) : R;
        voffA[i] = (unsigned)(R * K + C) * 2u; voffB[i] = (unsigned)(Rb * K + C) * 2u; }
    const size_t kstep = (size_t)(BK * 2);
    const size_t hstep = (size_t)HALF * K * 2;
    const size_t tstep = 2 * hstep;
    const unsigned ldsw = (unsigned)wid * 1024u;
    const int aoff = lds_byte(wr * 64 + fr, fq * 8), boff = lds_byte(wc * 32 + fr, fq * 8);
#define PG8_SA(b, h) (((b) * 2 + (h)) * HTB)
#define PG8_SB(b, h) ((4 + (b) * 2 + (h)) * HTB)
#define PG8_STAGE(bufoff, gbase, voff) do { _Pragma("unroll") for (int _i = 0; _i < 2; ++_i) \
        __builtin_amdgcn_global_load_lds((const unsigned*)((const char*)(gbase) + (voff)[_i]), (PG8_LAS unsigned*)(lds + (bufoff) + ldsw + _i * 8192), 16, 0, 0); } while (0)
#define PG8_LDA(dst, b, h) do { _Pragma("unroll") for (int m = 0; m < 4; ++m) _Pragma("unroll") for (int k = 0; k < 2; ++k) dst[m][k] = *(const PG8_LAS bf16x8*)(lds + PG8_SA(b, h) + aoff + m * 2048 + k * 1024); } while (0)
#define PG8_LDB(dst, b, h) do { _Pragma("unroll") for (int n = 0; n < 2; ++n) _Pragma("unroll") for (int k = 0; k < 2; ++k) dst[n][k] = *(const PG8_LAS bf16x8*)(lds + PG8_SB(b, h) + boff + n * 2048 + k * 1024); } while (0)
#define PG8_MMA(ai, bj, At, Bt) do { __builtin_amdgcn_s_setprio(1); _Pragma("unroll") for (int m = 0; m < 4; ++m) _Pragma("unroll") for (int n = 0; n < 2; ++n) _Pragma("unroll") for (int k = 0; k < 2; ++k) \
        acc[ai][bj][m][n] = __builtin_amdgcn_mfma_f32_16x16x32_bf16(Bt[n][k], At[m][k], acc[ai][bj][m][n], 0, 0, 0); __builtin_amdgcn_s_setprio(0); } while (0)
#define PG8_WAIT_V(n) asm volatile("s_waitcnt vmcnt(" #n ")" ::: "memory")
#define PG8_WAIT_L(n) asm volatile("s_waitcnt lgkmcnt(" #n ")" ::: "memory")
#define PG8_BAR __builtin_amdgcn_s_barrier()
#define PG8_SCHED __builtin_amdgcn_sched_barrier(0)
    Unit cur, nxt; int ui = 0;
    if (!S.next(0, cur)) return;
    f32x4 acc[2][2][4][2];
#pragma unroll
    for (int a = 0; a < 2; ++a)
#pragma unroll
        for (int b = 0; b < 2; ++b)
#pragma unroll
            for (int m = 0; m < 4; ++m)
#pragma unroll
                for (int n = 0; n < 2; ++n) acc[a][b][m][n] = (f32x4){0.f, 0.f, 0.f, 0.f};
    bf16x8 At[4][2], B0[2][2], B1[2][2];
    const char* cA = (const char*)g.A + (size_t)cur.pm * tstep; const char* cB = (const char*)g.Bt + (size_t)cur.pn * tstep;
    S.a_ready(cur);
    if constexpr (SP2) {
        PG8_STAGE(PG8_SB(0, 0), cB, voffB); PG8_STAGE(PG8_SB(0, 1), cB + hstep, voffB); PG8_STAGE(PG8_SA(0, 0), cA, voffA); PG8_STAGE(PG8_SA(0, 1), cA + hstep, voffA);
        if (wr == 1) PG8_BAR;
        PG8_WAIT_V(2); PG8_BAR;
        PG8_STAGE(PG8_SB(1, 0), cB + kstep, voffB); PG8_STAGE(PG8_SA(1, 0), cA + kstep, voffA); PG8_STAGE(PG8_SB(1, 1), cB + hstep + kstep, voffB);
        PG8_WAIT_V(6); PG8_BAR;
    } else {
        PG8_STAGE(PG8_SB(0, 0), cB, voffB); PG8_STAGE(PG8_SA(0, 0), cA, voffA); PG8_STAGE(PG8_SB(0, 1), cB + hstep, voffB); PG8_STAGE(PG8_SA(0, 1), cA + hstep, voffA);
        if (wr == 1) PG8_BAR;
        PG8_WAIT_V(4); PG8_BAR;
        PG8_STAGE(PG8_SB(1, 0), cB + kstep, voffB); PG8_STAGE(PG8_SA(1, 0), cA + kstep, voffA); PG8_STAGE(PG8_SB(1, 1), cB + hstep + kstep, voffB);
        PG8_WAIT_V(6); PG8_BAR;
    }
    for (;;) {
        const bool has_next = S.next(ui + 1, nxt);
        const char* nA = has_next ? (const char*)g.A + (size_t)nxt.pm * tstep : cA; const char* nB = has_next ? (const char*)g.Bt + (size_t)nxt.pn * tstep : cB;
        for (int t = 0; t < nt; t += 2) {
            const bool last = (t == nt - 2);
            const char* a1 = cA + (size_t)(t + 1) * kstep;
            const char* a2 = last ? nA : cA + (size_t)(t + 2) * kstep; const char* b2 = last ? nB : cB + (size_t)(t + 2) * kstep;
            const char* a3 = a2 + kstep; const char* b3 = b2 + kstep;
            if (last && has_next) S.a_ready(nxt);
            if constexpr (SP2) {
            PG8_LDB(B0, 0, 0); PG8_LDB(B1, 0, 1); PG8_SCHED; PG8_LDA(At, 0, 0); PG8_STAGE(PG8_SA(1, 1), a1 + hstep, voffA);
            PG8_WAIT_V(8); PG8_WAIT_L(0); PG8_BAR; PG8_MMA(0, 0, At, B0); PG8_MMA(0, 1, At, B1); PG8_BAR; PG8_SCHED;
            PG8_LDA(At, 0, 1); PG8_STAGE(PG8_SB(0, 0), b2, voffB); PG8_STAGE(PG8_SB(0, 1), b2 + hstep, voffB); PG8_STAGE(PG8_SA(0, 0), a2, voffA);
            PG8_WAIT_V(8); PG8_WAIT_L(0); PG8_BAR; PG8_MMA(1, 0, At, B0); PG8_MMA(1, 1, At, B1); PG8_BAR; PG8_SCHED;
            PG8_LDB(B0, 1, 0); PG8_LDB(B1, 1, 1); PG8_SCHED; PG8_LDA(At, 1, 0); PG8_STAGE(PG8_SA(0, 1), a2 + hstep, voffA);
            PG8_WAIT_V(8); PG8_WAIT_L(0); PG8_BAR; PG8_MMA(0, 0, At, B0); PG8_MMA(0, 1, At, B1); PG8_BAR; PG8_SCHED;
            PG8_LDA(At, 1, 1); PG8_STAGE(PG8_SB(1, 0), b3, voffB); PG8_STAGE(PG8_SB(1, 1), b3 + hstep, voffB); PG8_STAGE(PG8_SA(1, 0), a3, voffA);
            PG8_WAIT_V(8); PG8_WAIT_L(0); PG8_BAR; PG8_MMA(1, 0, At, B0); PG8_MMA(1, 1, At, B1); PG8_BAR; PG8_SCHED;
            } else {
            PG8_LDB(B0, 0, 0); PG8_SCHED; PG8_LDA(At, 0, 0); PG8_STAGE(PG8_SA(1, 1), a1 + hstep, voffA);
            PG8_WAIT_L(8); PG8_BAR; PG8_WAIT_L(0); PG8_MMA(0, 0, At, B0); PG8_BAR; PG8_SCHED;
            PG8_LDB(B1, 0, 1); PG8_STAGE(PG8_SB(0, 0), b2, voffB);
            PG8_BAR; PG8_WAIT_L(0); PG8_MMA(0, 1, At, B1); PG8_BAR;
            PG8_LDA(At, 0, 1); PG8_STAGE(PG8_SA(0, 0), a2, voffA);
            PG8_BAR; PG8_WAIT_L(0); PG8_MMA(1, 0, At, B0); PG8_BAR; PG8_SCHED;
            PG8_STAGE(PG8_SB(0, 1), b2 + hstep, voffB);
            PG8_WAIT_V(6); PG8_BAR; PG8_MMA(1, 1, At, B1); PG8_BAR;
            PG8_LDB(B0, 1, 0); PG8_SCHED; PG8_LDA(At, 1, 0); PG8_STAGE(PG8_SA(0, 1), a2 + hstep, voffA);
            PG8_WAIT_L(8); PG8_BAR; PG8_WAIT_L(0); PG8_MMA(0, 0, At, B0); PG8_BAR; PG8_SCHED;
            PG8_LDB(B1, 1, 1); PG8_STAGE(PG8_SB(1, 0), b3, voffB);
            PG8_BAR; PG8_WAIT_L(0); PG8_MMA(0, 1, At, B1); PG8_BAR;
            PG8_LDA(At, 1, 1); PG8_STAGE(PG8_SA(1, 0), a3, voffA);
            PG8_BAR; PG8_WAIT_L(0); PG8_MMA(1, 0, At, B0); PG8_BAR; PG8_SCHED;
            PG8_STAGE(PG8_SB(1, 1), b3 + hstep, voffB);
            PG8_WAIT_V(6); PG8_BAR; PG8_MMA(1, 1, At, B1); PG8_BAR;
            }
        }
        if constexpr (ALIGN_EPI) { if (wr == 0) PG8_BAR; }
        if constexpr (!Epi::AFTER_DRAIN) { E(acc, cur, ui, wr, wc, fr, fq); S.done(cur); }
        if (!has_next) break;
        if (!E.keep(cur))
#pragma unroll
        for (int a = 0; a < 2; ++a)
#pragma unroll
            for (int b = 0; b < 2; ++b)
#pragma unroll
                for (int m = 0; m < 4; ++m)
#pragma unroll
                    for (int n = 0; n < 2; ++n) acc[a][b][m][n] = (f32x4){0.f, 0.f, 0.f, 0.f};
        cur = nxt; cA = nA; cB = nB; ++ui;
        if constexpr (ALIGN_EPI) { if (wr == 1) PG8_BAR; }
    }
    PG8_WAIT_V(0);
    if constexpr (!ALIGN_EPI) { if (wr == 0) PG8_BAR; }
    PG8_BAR;
    if constexpr (Epi::AFTER_DRAIN) { E.fused(acc, cur, wr, wc, fr, fq, lds, wid, lane); S.done(cur); }
#undef PG8_SA
#undef PG8_SB
#undef PG8_STAGE
#undef PG8_LDA
#undef PG8_LDB
#undef PG8_MMA
#undef PG8_WAIT_V
#undef PG8_WAIT_L
#undef PG8_BAR
#undef PG8_SCHED
}
}

using namespace pg8;
#define LAS __attribute__((address_space(3)))
typedef unsigned u32x2 __attribute__((ext_vector_type(2)));

constexpr int T_TOK = 16384, PROJ = 8720, NP = 8704, NPT = 8960;
constexpr size_t MiB = 1ull << 20;
constexpr size_t OFF_Q = 0, OFF_Z = 32 * MiB, OFF_OG = 64 * MiB, OFF_GA = 96 * MiB, OFF_GM = 128 * MiB, OFF_MV = 160 * MiB,
                 OFF_MQ = 192 * MiB, OFF_MK = 208 * MiB, OFF_K = 224 * MiB, OFF_V = 232 * MiB, OFF_WAT = 240 * MiB,
                 OFF_WOT = 244 * MiB, OFF_IF = 246 * MiB, OFF_BIASP = 247 * MiB, OFF_MLOC = OFF_BIASP + 65536,
                 OFF_GSUM = OFF_MLOC + 8192, OFF_MPREV = OFF_GSUM + 8192, OFF_BAR = OFF_MPREV + 8192, OFF_PCNT = OFF_BAR + 16384, OFF_ROWSS = OFF_PCNT + 16384, WS_END = OFF_ROWSS + 65536;
constexpr size_t OUT_H = 0, OUT_WTIN = 32 * MiB, OUT_CST = 0;
constexpr int BIAS_UNITS = 12;
constexpr int LDS_BYTES = 131072 + 16 + BIAS_UNITS * 1024;
constexpr int HSZ = 49408;

struct Params {
    const float *x, *norm_w, *w_in, *b_in, *sinks, *conv_w, *conv_b, *mnorm_w, *w_ba, *w_bm, *w_out, *fnorm_w;
    float* out; unsigned char* ws;
    int ph_lo, ph_hi;
};

__device__ __forceinline__ float bf_lo(unsigned w) { return __uint_as_float(w << 16); }
__device__ __forceinline__ float bf_hi(unsigned w) { return __uint_as_float(w & 0xffff0000u); }
__device__ __forceinline__ float bf2f(bf16_t b) { return __uint_as_float(((unsigned)b) << 16); }
__device__ __forceinline__ bf16_t f2bf(float f) { unsigned u = __float_as_uint(f); u += 0x7fffu + ((u >> 16) & 1u); return (bf16_t)(u >> 16); }
__device__ __forceinline__ float sigm(float x) { return __builtin_amdgcn_rcpf(1.f + __builtin_amdgcn_exp2f(-1.44269504f * x)); }
__device__ __forceinline__ float silu(float x) { return x * __builtin_amdgcn_rcpf(1.f + __builtin_amdgcn_exp2f(-1.44269504f * x)); }
__device__ __forceinline__ float wave_sum(float v) {
#pragma unroll
    for (int o = 1; o < 64; o <<= 1) v += __shfl_xor(v, o);
    return v;
}
__device__ __forceinline__ float wave_max(float v) {
#pragma unroll
    for (int o = 1; o < 64; o <<= 1) v = fmaxf(v, __shfl_xor(v, o));
    return v;
}
__device__ __forceinline__ f32x4 mfma16(bf16x8 a, bf16x8 b, f32x4 c) { return __builtin_amdgcn_mfma_f32_16x16x32_bf16(a, b, c, 0, 0, 0); }

__device__ __forceinline__ int src_col(int np) {
    if (np < 4608) return np;
    if (np < 6656) { const int t = (np - 4608) >> 8, r = np & 255; return (r < 128) ? (4624 + 128 * t + r) : (5648 + 128 * t + (r - 128)); }
    if (np >= 8704) return 4608 + (np - 8704);
    { const int t = (np - 6656) >> 8, r = np & 255; return (r < 128) ? (6672 + 128 * t + r) : (7696 + 128 * t + (r - 128)); }
}

__device__ __forceinline__ void transpose_item(const float* W, int N, int n_src0, bf16_t* WT, int row0, int k0, LAS float* scr, int lane) {
    f32x4 tv[8]; const int kr = lane >> 3, nc = (lane & 7) * 4;
#pragma unroll
    for (int i = 0; i < 8; ++i) tv[i] = __builtin_nontemporal_load((const f32x4*)(W + (size_t)(k0 + kr + 8 * i) * N + n_src0 + nc));
#pragma unroll
    for (int i = 0; i < 8; ++i) { LAS float* d = scr + (kr + 8 * i) * 33 + nc; d[0] = tv[i].x; d[1] = tv[i].y; d[2] = tv[i].z; d[3] = tv[i].w; }
    asm volatile("s_waitcnt lgkmcnt(0)" ::: "memory");
    const int c = lane & 7;
#pragma unroll
    for (int j = 0; j < 4; ++j) { const int n = (lane >> 3) + 8 * j; const LAS float* s = scr + (8 * c) * 33 + n;
        u32x4 o; o.x = cvt_pk_bf16(s[0], s[33]); o.y = cvt_pk_bf16(s[66], s[99]); o.z = cvt_pk_bf16(s[132], s[165]); o.w = cvt_pk_bf16(s[198], s[231]);
        *(u32x4*)(WT + (size_t)(row0 + n) * 1024 + k0 + 8 * c) = o; }
    asm volatile("s_waitcnt lgkmcnt(0)" ::: "memory");
}

__device__ __forceinline__ void square_transposes(const Params& p, LAS unsigned char* lds, int widx, int nw) {
    const int lane = threadIdx.x & 63, wave = threadIdx.x >> 6;
    bf16_t* WaT = (bf16_t*)(p.ws + OFF_WAT); bf16_t* WoT = (bf16_t*)(p.ws + OFF_WOT);
    LAS float* scr = (LAS float*)lds + wave * (64 * 33);
    constexpr int I_SQ = 16 * 32;
    for (int it = widx; it < 3 * I_SQ; it += nw) { int r = it; const int mtx = r / I_SQ; r %= I_SQ; const int kb = r / 32, nb = r % 32;
        const float* W = mtx == 0 ? p.w_ba : (mtx == 1 ? p.w_bm : p.w_out);
        bf16_t* WT = mtx == 2 ? WoT : WaT; const int row0 = (mtx == 1 ? 1024 : 0) + nb * 32;
        transpose_item(W, 1024, nb * 32, WT, row0, kb * 64, scr, lane); }
}
__device__ __forceinline__ void phase0(const Params& p, LAS unsigned char* lds, int G) {
    const int tid = threadIdx.x, lane = tid & 63, wave = tid >> 6;
    const int gw = blockIdx.x * 8 + wave, NGW = G * 8;
    bf16_t* WtIn = (bf16_t*)((unsigned char*)p.out + OUT_WTIN);
    bf16_t* WaT = (bf16_t*)(p.ws + OFF_WAT);
    bf16_t* WoT = (bf16_t*)(p.ws + OFF_WOT);
    LAS float* scr = (LAS float*)lds + wave * (64 * 33);
    constexpr int NBLK = NP / 32 + 1, I_IN = 16 * NBLK, I_SQ = 16 * 32;
    for (int it = gw; it < I_IN; it += NGW) { const int kb = it / NBLK, nb = it % NBLK; transpose_item(p.w_in, PROJ, src_col(nb * 32), WtIn, nb * 32, kb * 64, scr, lane); }
    if (G != 256) square_transposes(p, lds, gw, NGW);
    float* biasp = (float*)(p.ws + OFF_BIASP);
    for (int i = blockIdx.x * 512 + tid; i < NP + 32; i += G * 512) biasp[i] = p.b_in[src_col(i)];
    bf16_t* H = (bf16_t*)((unsigned char*)p.out + OUT_H);
    f32x4 nwv[4], nxt[4];
#pragma unroll
    for (int j = 0; j < 4; ++j) { nwv[j] = ((const f32x4*)p.norm_w)[64 * j + lane]; nxt[j] = __builtin_nontemporal_load((const f32x4*)(p.x + (size_t)gw * 1024) + lane + 64 * j); }
    for (int row = gw; row < T_TOK; row += NGW) {
        f32x4 v[4]; float ss = 0.f;
#pragma unroll
        for (int j = 0; j < 4; ++j) v[j] = nxt[j];
        if (row + NGW < T_TOK) {
#pragma unroll
            for (int j = 0; j < 4; ++j) nxt[j] = __builtin_nontemporal_load((const f32x4*)(p.x + (size_t)(row + NGW) * 1024) + lane + 64 * j); }
#pragma unroll
        for (int j = 0; j < 4; ++j) ss += (v[j].x * v[j].x + v[j].y * v[j].y) + (v[j].z * v[j].z + v[j].w * v[j].w);
        ss = wave_sum(ss);
        const float rstd = rsqrtf(ss * (1.f / 1024.f) + 1e-6f);
#pragma unroll
        for (int j = 0; j < 4; ++j) { const f32x4 nw = nwv[j]; v[j] = v[j] * rstd * nw;
            u32x2 o; o.x = cvt_pk_bf16(v[j].x, v[j].y); o.y = cvt_pk_bf16(v[j].z, v[j].w);
            *((u32x2*)(H + (size_t)row * 1024) + 64 * j + lane) = o; }
    }
}

struct Epi1 {
    static constexpr bool PERM = true, AFTER_DRAIN = false;
    unsigned char* ws; const LAS float* biasl;
    __device__ __forceinline__ bool keep(const Unit&) const { return false; }
    __device__ __forceinline__ void operator()(const f32x4 (&acc)[2][2][4][2], const Unit& u, int ui, int wr, int wc, int fr, int fq) const {
        const int pn = u.pn, row0 = u.pm * BM + wr * 64 + fr, lc = wc * 32 + 8 * fq;
        f32x4 bv[2][2];
#pragma unroll
        for (int bj = 0; bj < 2; ++bj)
#pragma unroll
            for (int n = 0; n < 2; ++n) bv[bj][n] = *(const LAS f32x4*)(biasl + ui * 256 + bj * HALF + lc + 4 * n);
        if (pn == 34) {
            if (wc == 0 && fq < 2) { float* IF = (float*)(ws + OFF_IF);
#pragma unroll
                for (int ai = 0; ai < 2; ++ai)
#pragma unroll
                    for (int m = 0; m < 4; ++m) { float* gp = IF + (size_t)(row0 + ai * HALF + m * 16) * 16 + 8 * fq;
                        *(f32x4*)gp = acc[ai][0][m][0] + bv[0][0]; *(f32x4*)(gp + 4) = acc[ai][0][m][1] + bv[0][1]; } }
            return;
        }
        if (pn >= 26) {
            bf16_t* RA = (bf16_t*)(ws + OFF_GA); bf16_t* GMb = (bf16_t*)(ws + OFF_GM); const int cb = (pn - 26) * 128 + lc;
#pragma unroll
            for (int ai = 0; ai < 2; ++ai)
#pragma unroll
                for (int m = 0; m < 4; ++m) { float ra[8], gm[8];
#pragma unroll
                    for (int n = 0; n < 2; ++n)
#pragma unroll
                        for (int i = 0; i < 4; ++i) { const float a = acc[ai][0][m][n][i] + bv[0][n][i], b = acc[ai][1][m][n][i] + bv[1][n][i];
                            const float da = 1.f + __builtin_amdgcn_exp2f(-1.44269504f * a), db = 1.f + __builtin_amdgcn_exp2f(-1.44269504f * b);
                            ra[4 * n + i] = db * __builtin_amdgcn_rcpf(da); gm[4 * n + i] = __builtin_amdgcn_rcpf(db); }
                    u32x4 w; w.x = cvt_pk_bf16(ra[0], ra[1]); w.y = cvt_pk_bf16(ra[2], ra[3]); w.z = cvt_pk_bf16(ra[4], ra[5]); w.w = cvt_pk_bf16(ra[6], ra[7]);
                    const size_t o = (size_t)(row0 + ai * HALF + m * 16) * 1024 + cb;
                    *(u32x4*)(RA + o) = w;
                    w.x = cvt_pk_bf16(gm[0], gm[1]); w.y = cvt_pk_bf16(gm[2], gm[3]); w.z = cvt_pk_bf16(gm[4], gm[5]); w.w = cvt_pk_bf16(gm[6], gm[7]);
                    *(u32x4*)(GMb + o) = w; }
            return;
        }
        if (pn >= 18 && pn < 26) {
            bf16_t* OG = (bf16_t*)(ws + OFF_OG); const int cb = (pn - 18) * 128 + lc;
#pragma unroll
            for (int ai = 0; ai < 2; ++ai)
#pragma unroll
                for (int m = 0; m < 4; ++m) { float r[8];
#pragma unroll
                    for (int n = 0; n < 2; ++n)
#pragma unroll
                        for (int i = 0; i < 4; ++i) { const float o = acc[ai][0][m][n][i] + bv[0][n][i], z = acc[ai][1][m][n][i] + bv[1][n][i]; r[4 * n + i] = sigm(o) * silu(z); }
                    u32x4 w; w.x = cvt_pk_bf16(r[0], r[1]); w.y = cvt_pk_bf16(r[2], r[3]); w.z = cvt_pk_bf16(r[4], r[5]); w.w = cvt_pk_bf16(r[6], r[7]);
                    *(u32x4*)(OG + (size_t)(row0 + ai * HALF + m * 16) * 1024 + cb) = w; }
            return;
        }
        size_t off; int ld, c0, act;
        if (pn < 4) { off = OFF_Q; ld = 1024; c0 = pn * 256; act = 1; }
        else if (pn == 4) { off = OFF_K; ld = 256; c0 = 0; act = 0; }
        else if (pn == 5) { off = OFF_V; ld = 256; c0 = 0; act = 0; }
        else if (pn < 10) { off = OFF_Z; ld = 1024; c0 = (pn - 6) * 256; act = 2; }
        else if (pn < 12) { off = OFF_MQ; ld = 512; c0 = (pn - 10) * 256; act = 0; }
        else if (pn < 14) { off = OFF_MK; ld = 512; c0 = (pn - 12) * 256; act = 0; }
        else { off = OFF_MV; ld = 1024; c0 = (pn - 14) * 256; act = 0; }
        bf16_t* dst = (bf16_t*)(ws + off) + c0 + lc;
#pragma unroll
        for (int ai = 0; ai < 2; ++ai)
#pragma unroll
            for (int m = 0; m < 4; ++m) { bf16_t* rowp = dst + (size_t)(row0 + ai * HALF + m * 16) * ld;
#pragma unroll
                for (int bj = 0; bj < 2; ++bj) { f32x4 v0 = acc[ai][bj][m][0] + bv[bj][0], v1 = acc[ai][bj][m][1] + bv[bj][1];
                    if (act == 1) { v0 = v0 * 0.18033688f; v1 = v1 * 0.18033688f; }
                    else if (act == 2) {
#pragma unroll
                        for (int i = 0; i < 4; ++i) { v0[i] = silu(v0[i]); v1[i] = silu(v1[i]); } }
                    else if (act == 3) {
#pragma unroll
                        for (int i = 0; i < 4; ++i) { v0[i] = sigm(v0[i]); v1[i] = sigm(v1[i]); } }
                    u32x4 w; w.x = cvt_pk_bf16(v0[0], v0[1]); w.y = cvt_pk_bf16(v0[2], v0[3]); w.z = cvt_pk_bf16(v1[0], v1[1]); w.w = cvt_pk_bf16(v1[2], v1[3]);
                    *(u32x4*)(rowp + bj * HALF) = w; } }
    }
};

__device__ __forceinline__ void attn_item(const Params& p, LAS unsigned char* lds, int it) {
    const int tid = threadIdx.x, lane = tid & 63, wave = tid >> 6, fr = lane & 15, fq = lane >> 4;
    const int b = it >> 7, kvh = (it >> 5) & 3, qb = it & 31, t0 = b * 4096 + qb * 128;
    LAS bf16_t* Ks = (LAS bf16_t*)lds;
    LAS bf16_t* Vs = Ks + 256 * 72;
    const bf16_t* Kb = (const bf16_t*)(p.ws + OFF_K); const bf16_t* Vb = (const bf16_t*)(p.ws + OFF_V);
    const bf16_t* Q = (const bf16_t*)(p.ws + OFF_Q); bf16_t* Z = (bf16_t*)(p.ws + OFF_Z);
    const unsigned vtr_base = (unsigned)(size_t)Vs + (unsigned)((4 * fq + ((lane & 15) >> 2)) * 144 + (lane & 3) * 8);
    const int g = wave & 3, half = wave >> 2, hq = kvh * 4 + g; const float sink = p.sinks[hq] * 1.44269504f; const int dlt = fq * 4 - fr;
    u32x4 kraw[4], vraw[4];
#pragma unroll
    for (int i = 0; i < 4; ++i) { const int c = tid + 512 * i, sj = c >> 3, dc = c & 7; kraw[i] = (u32x4){0u, 0u, 0u, 0u}; vraw[i] = (u32x4){0u, 0u, 0u, 0u};
        if (qb > 0 || sj >= 128) { const size_t off = (size_t)(t0 - 128 + sj) * 256 + kvh * 64 + dc * 8; kraw[i] = *(const u32x4*)(Kb + off); vraw[i] = *(const u32x4*)(Vb + off); } }
    bf16x8 qf[2][2][2]; u32x2 zz[2][2][4];
#pragma unroll
    for (int qc = 0; qc < 2; ++qc)
#pragma unroll
        for (int qs = 0; qs < 2; ++qs) { const size_t ro = (size_t)(t0 + half * 64 + qc * 32 + qs * 16 + fr) * 1024 + hq * 64;
#pragma unroll
            for (int ks = 0; ks < 2; ++ks) qf[qc][qs][ks] = *(const bf16x8*)(Q + ro + ks * 32 + fq * 8);
#pragma unroll
            for (int dt = 0; dt < 4; ++dt) zz[qc][qs][dt] = *(const u32x2*)(Z + ro + dt * 16 + fq * 4); }
#pragma unroll
    for (int i = 0; i < 4; ++i) { const int c = tid + 512 * i, sj = c >> 3, dc = c & 7;
        *(LAS u32x4*)(Ks + sj * 72 + dc * 8) = kraw[i]; *(LAS u32x4*)(Vs + sj * 72 + dc * 8) = vraw[i]; }
    __syncthreads();
#pragma unroll
    for (int qc = 0; qc < 2; ++qc) {
        const int i0 = half * 64 + qc * 32;
        f32x4 s[10][2];
#pragma unroll
        for (int kt = 0; kt < 10; ++kt) { s[kt][0] = (f32x4){0.f, 0.f, 0.f, 0.f}; s[kt][1] = (f32x4){0.f, 0.f, 0.f, 0.f};
#pragma unroll
            for (int ks = 0; ks < 2; ++ks) { const bf16x8 kf = *(const LAS bf16x8*)(Ks + (i0 + kt * 16 + fr) * 72 + ks * 32 + fq * 8);
                s[kt][0] = mfma16(kf, qf[qc][0][ks], s[kt][0]); s[kt][1] = mfma16(kf, qf[qc][1][ks], s[kt][1]); } }
        float mx[2] = {sink, sink};
        const int lowtile = (qb == 0) ? ((128 - i0) >> 4) : 0;
#pragma unroll
        for (int kt = 0; kt < 10; ++kt) {
            if (kt < lowtile) { s[kt][0] = (f32x4){-INFINITY, -INFINITY, -INFINITY, -INFINITY}; s[kt][1] = s[kt][0]; }
#pragma unroll
            for (int qs = 0; qs < 2; ++qs)
#pragma unroll
                for (int r = 0; r < 4; ++r) { float sv = s[kt][qs][r];
                    if (kt - qs <= 0) sv = ((kt - qs) * 16 + r + dlt > 0) ? sv : -INFINITY;
                    if (kt - qs >= 8) sv = ((kt - qs) * 16 + r + dlt <= 128) ? sv : -INFINITY;
                    s[kt][qs][r] = sv; mx[qs] = fmaxf(mx[qs], sv); } }
        float inv[2];
#pragma unroll
        for (int qs = 0; qs < 2; ++qs) { mx[qs] = fmaxf(mx[qs], __shfl_xor(mx[qs], 16)); mx[qs] = fmaxf(mx[qs], __shfl_xor(mx[qs], 32)); }
        float sum[2] = {0.f, 0.f};
#pragma unroll
        for (int kt = 0; kt < 10; ++kt)
#pragma unroll
            for (int qs = 0; qs < 2; ++qs)
#pragma unroll
                for (int r = 0; r < 4; ++r) { const float pv = __builtin_amdgcn_exp2f(s[kt][qs][r] - mx[qs]); s[kt][qs][r] = pv; sum[qs] += pv; }
#pragma unroll
        for (int qs = 0; qs < 2; ++qs) { sum[qs] += __shfl_xor(sum[qs], 16); sum[qs] += __shfl_xor(sum[qs], 32); inv[qs] = __builtin_amdgcn_rcpf(sum[qs] + __builtin_amdgcn_exp2f(sink - mx[qs])); }
        f32x4 o[4][2];
#pragma unroll
        for (int dt = 0; dt < 4; ++dt) { o[dt][0] = (f32x4){0.f, 0.f, 0.f, 0.f}; o[dt][1] = (f32x4){0.f, 0.f, 0.f, 0.f}; }
#pragma unroll
        for (int kp = 0; kp < 5; ++kp) {
            bf16x8 pf[2];
#pragma unroll
            for (int qs = 0; qs < 2; ++qs) { u32x4 w; w.x = cvt_pk_bf16(s[2 * kp][qs][0], s[2 * kp][qs][1]); w.y = cvt_pk_bf16(s[2 * kp][qs][2], s[2 * kp][qs][3]);
                w.z = cvt_pk_bf16(s[2 * kp + 1][qs][0], s[2 * kp + 1][qs][1]); w.w = cvt_pk_bf16(s[2 * kp + 1][qs][2], s[2 * kp + 1][qs][3]); pf[qs] = __builtin_bit_cast(bf16x8, w); }
            u32x2 t0r[4], t1r[4];
            { const unsigned a = vtr_base + (unsigned)((i0 + kp * 32) * 144);
              asm volatile("ds_read_b64_tr_b16 %0, %8\n\tds_read_b64_tr_b16 %1, %8 offset:2304\n\tds_read_b64_tr_b16 %2, %8 offset:32\n\tds_read_b64_tr_b16 %3, %8 offset:2336\n\t"
                           "ds_read_b64_tr_b16 %4, %8 offset:64\n\tds_read_b64_tr_b16 %5, %8 offset:2368\n\tds_read_b64_tr_b16 %6, %8 offset:96\n\tds_read_b64_tr_b16 %7, %8 offset:2400\n\ts_waitcnt lgkmcnt(0)"
                           : "=&v"(t0r[0]), "=&v"(t1r[0]), "=&v"(t0r[1]), "=&v"(t1r[1]), "=&v"(t0r[2]), "=&v"(t1r[2]), "=&v"(t0r[3]), "=&v"(t1r[3]) : "v"(a) : "memory"); }
#pragma unroll
            for (int dt = 0; dt < 4; ++dt) { u32x4 aw; aw.x = t0r[dt].x; aw.y = t0r[dt].y; aw.z = t1r[dt].x; aw.w = t1r[dt].y; const bf16x8 vf = __builtin_bit_cast(bf16x8, aw);
                o[dt][0] = mfma16(vf, pf[0], o[dt][0]); o[dt][1] = mfma16(vf, pf[1], o[dt][1]); } }
#pragma unroll
        for (int qs = 0; qs < 2; ++qs)
#pragma unroll
            for (int dt = 0; dt < 4; ++dt) { bf16_t* zp = Z + (size_t)(t0 + i0 + qs * 16 + fr) * 1024 + hq * 64 + dt * 16 + fq * 4;
                const u32x2 z2 = zz[qc][qs][dt]; u32x2 w;
                w.x = cvt_pk_bf16(o[dt][qs][0] * inv[qs] * bf_lo(z2.x), o[dt][qs][1] * inv[qs] * bf_hi(z2.x));
                w.y = cvt_pk_bf16(o[dt][qs][2] * inv[qs] * bf_lo(z2.y), o[dt][qs][3] * inv[qs] * bf_hi(z2.y));
                *(u32x2*)zp = w; }
    }
    __syncthreads();
}

__device__ __forceinline__ void gates_from(float f, int lane, float& bcum) {
    float lf = fminf(f, 0.f) - log1pf(expf(-fabsf(f)));
#pragma unroll
    for (int o = 1; o < 64; o <<= 1) { const float t = __shfl_up(lf, o); if (lane >= o) lf += t; }
    bcum = lf;
}
__device__ __forceinline__ void conv_load(const bf16_t* U, int t, int pos, int bcol, u32x4 (&r)[4]) {
#pragma unroll
    for (int j = 0; j < 4; ++j) { r[j] = (u32x4){0u, 0u, 0u, 0u}; if (pos - 3 + j >= 0) r[j] = *(const u32x4*)(U + (size_t)(t - 3 + j) * 512 + bcol); }
}
__device__ __forceinline__ void conv_compute(const Params& p, const u32x4 (&r)[4], int cch, float (&o)[8]) {
    const f32x4* cb = (const f32x4*)(p.conv_b + cch); const f32x4 b0 = cb[0], b1 = cb[1];
    o[0] = b0.x; o[1] = b0.y; o[2] = b0.z; o[3] = b0.w; o[4] = b1.x; o[5] = b1.y; o[6] = b1.z; o[7] = b1.w;
#pragma unroll
    for (int j = 0; j < 4; ++j) { const u32x4 w = r[j];
        const f32x4* cw = (const f32x4*)(p.conv_w + j * 1024 + cch); const f32x4 w0 = cw[0], w1 = cw[1];
        o[0] += w0.x * bf_lo(w.x); o[1] += w0.y * bf_hi(w.x); o[2] += w0.z * bf_lo(w.y); o[3] += w0.w * bf_hi(w.y);
        o[4] += w1.x * bf_lo(w.z); o[5] += w1.y * bf_hi(w.z); o[6] += w1.z * bf_lo(w.w); o[7] += w1.w * bf_hi(w.w); }
}
__device__ __forceinline__ void vn_load(const Params& p, int ts, int hh, int hl, u32x4 (&vraw)[4]) {
    const bf16_t* MV = (const bf16_t*)(p.ws + OFF_MV);
#pragma unroll
    for (int i = 0; i < 4; ++i) { const int task = hl + 256 * i, vg = task & 15, l = task >> 4; vraw[i] = *(const u32x4*)(MV + (size_t)(ts + l) * 1024 + hh * 128 + vg * 8); }
}
__device__ __forceinline__ void vn_store(LAS bf16_t* Vn, int hl, const u32x4 (&vraw)[4]) {
#pragma unroll
    for (int i = 0; i < 4; ++i) { const int task = hl + 256 * i, vg = task & 15, l = task >> 4; *(LAS u32x4*)(Vn + l * 152 + vg * 8) = vraw[i]; }
    if (hl < 128) { const int l = hl >> 1, h2 = hl & 1; *(LAS u32x4*)(Vn + l * 152 + 128 + h2 * 8) = (u32x4){h2 ? 0u : 0x3F80u, 0u, 0u, 0u}; }
}

__device__ __forceinline__ void mlstm_pass1(const Params& p, LAS unsigned char* lds, int itp) {
    const int tid = threadIdx.x, lane = tid & 63, wave = __builtin_amdgcn_readfirstlane(tid >> 6), fr = lane & 15, fq = lane >> 4;
    const int sub = wave >> 2, hw = wave & 3, hl = tid & 255;
    const int item = 2 * itp + sub, b = item >> 9, hh = (item >> 6) & 7, c = item & 63, ts = b * 4096 + c * 64;
    LAS unsigned char* base = lds + sub * HSZ;
    LAS float* wts = (LAS float*)base;
    LAS bf16_t* Kw = (LAS bf16_t*)(base + 2048);
    LAS bf16_t* Vn = Kw + 64 * 72;
    const float* IF = (const float*)(p.ws + OFF_IF);
    const bf16_t* MK = (const bf16_t*)(p.ws + OFF_MK);
    float gf = 0.f, gi = 0.f;
    if (hw == 0) { gf = IF[(size_t)(ts + lane) * 16 + 8 + hh]; gi = IF[(size_t)(ts + lane) * 16 + hh]; }
    u32x4 kraw[2][4], vraw[4];
#pragma unroll
    for (int i = 0; i < 2; ++i) { const int task = hl + 256 * i, kg = task & 7, l = task >> 3; conv_load(MK, ts + l, c * 64 + l, hh * 64 + kg * 8, kraw[i]); }
    vn_load(p, ts, hh, hl, vraw);
    if (hw == 0) { float bc; gates_from(gf, lane, bc);
        const float gs = __shfl(bc, 63), a = gs - bc + gi, ml = wave_max(a);
        wts[lane] = expf(a - ml);
        if (lane == 0) { ((float*)(p.ws + OFF_MLOC))[item] = ml; ((float*)(p.ws + OFF_GSUM))[item] = gs; } }
    __syncthreads();
#pragma unroll
    for (int i = 0; i < 2; ++i) { const int task = hl + 256 * i, kg = task & 7, l = task >> 3; float kc[8]; conv_compute(p, kraw[i], 512 + hh * 64 + kg * 8, kc);
        const float w = wts[l]; u32x4 wk;
        wk.x = cvt_pk_bf16(silu(kc[0]) * w, silu(kc[1]) * w); wk.y = cvt_pk_bf16(silu(kc[2]) * w, silu(kc[3]) * w);
        wk.z = cvt_pk_bf16(silu(kc[4]) * w, silu(kc[5]) * w); wk.w = cvt_pk_bf16(silu(kc[6]) * w, silu(kc[7]) * w);
        *(LAS u32x4*)(Kw + l * 72 + kg * 8) = wk; }
    vn_store(Vn, hl, vraw);
    __syncthreads();
    f32x4 acc[9];
#pragma unroll
    for (int vt = 0; vt < 9; ++vt) acc[vt] = (f32x4){0.f, 0.f, 0.f, 0.f};
    const unsigned vtr1 = (unsigned)(size_t)Vn + (unsigned)((8 * fq + ((lane & 15) >> 2)) * 304 + (lane & 3) * 8);
    const unsigned ktr1 = (unsigned)(size_t)Kw + (unsigned)((8 * fq + ((lane & 15) >> 2)) * 144 + (lane & 3) * 8 + hw * 32);
#pragma unroll
    for (int ks = 0; ks < 2; ++ks) { u32x2 kt0, kt1;
        { const unsigned a = ktr1 + (unsigned)(ks * 4608);
          asm volatile("ds_read_b64_tr_b16 %0, %2\n\tds_read_b64_tr_b16 %1, %2 offset:576\n\ts_waitcnt lgkmcnt(0)" : "=&v"(kt0), "=&v"(kt1) : "v"(a) : "memory"); }
        u32x4 bw; bw.x = kt0.x; bw.y = kt0.y; bw.z = kt1.x; bw.w = kt1.y; const bf16x8 bf = __builtin_bit_cast(bf16x8, bw);
        u32x2 tr[9][2];
        { const unsigned a = vtr1 + (unsigned)(ks * 9728);
          asm volatile("ds_read_b64_tr_b16 %0, %18\n\tds_read_b64_tr_b16 %1, %18 offset:1216\n\tds_read_b64_tr_b16 %2, %18 offset:32\n\tds_read_b64_tr_b16 %3, %18 offset:1248\n\tds_read_b64_tr_b16 %4, %18 offset:64\n\tds_read_b64_tr_b16 %5, %18 offset:1280\n\tds_read_b64_tr_b16 %6, %18 offset:96\n\tds_read_b64_tr_b16 %7, %18 offset:1312\n\tds_read_b64_tr_b16 %8, %18 offset:128\n\tds_read_b64_tr_b16 %9, %18 offset:1344\n\tds_read_b64_tr_b16 %10, %18 offset:160\n\tds_read_b64_tr_b16 %11, %18 offset:1376\n\tds_read_b64_tr_b16 %12, %18 offset:192\n\tds_read_b64_tr_b16 %13, %18 offset:1408\n\tds_read_b64_tr_b16 %14, %18 offset:224\n\tds_read_b64_tr_b16 %15, %18 offset:1440\n\tds_read_b64_tr_b16 %16, %18 offset:256\n\tds_read_b64_tr_b16 %17, %18 offset:1472\n\ts_waitcnt lgkmcnt(0)" : "=&v"(tr[0][0]), "=&v"(tr[0][1]), "=&v"(tr[1][0]), "=&v"(tr[1][1]), "=&v"(tr[2][0]), "=&v"(tr[2][1]), "=&v"(tr[3][0]), "=&v"(tr[3][1]), "=&v"(tr[4][0]), "=&v"(tr[4][1]), "=&v"(tr[5][0]), "=&v"(tr[5][1]), "=&v"(tr[6][0]), "=&v"(tr[6][1]), "=&v"(tr[7][0]), "=&v"(tr[7][1]), "=&v"(tr[8][0]), "=&v"(tr[8][1]) : "v"(a) : "memory"); }
#pragma unroll
        for (int vt = 0; vt < 9; ++vt) { u32x4 aw; aw.x = tr[vt][0].x; aw.y = tr[vt][0].y; aw.z = tr[vt][1].x; aw.w = tr[vt][1].y; acc[vt] = mfma16(__builtin_bit_cast(bf16x8, aw), bf, acc[vt]); } }
    bf16_t* cst = (bf16_t*)((unsigned char*)p.out + OUT_CST) + (size_t)item * 9216;
#pragma unroll
    for (int vt = 0; vt < 9; ++vt)
#pragma unroll
        for (int r = 0; r < 4; ++r) cst[(vt * 16 + fq * 4 + r) * 64 + hw * 16 + fr] = f2bf(acc[vt][r]);
    __syncthreads();
}


__device__ __forceinline__ void mlstm_scan(const Params& p, int G) {
    const float* mloc = (const float*)(p.ws + OFF_MLOC); const float* gsum = (const float*)(p.ws + OFF_GSUM); float* mprev = (float*)(p.ws + OFF_MPREV);
    bf16_t* cst = (bf16_t*)((unsigned char*)p.out + OUT_CST);
    for (int task = blockIdx.x * 512 + threadIdx.x; task < 32 * 2304; task += G * 512) {
        const int bh = task / 2304, e = task % 2304;
        float s0 = 0.f, s1 = 0.f, s2 = 0.f, s3 = 0.f, m = -1e30f;
        u32x2* ptr = (u32x2*)(cst + (size_t)bh * 64 * 9216 + e * 4);
        for (int c0 = 0; c0 < 64; c0 += 16) { u32x2 clv[16]; float glv[16], mlv[16];
#pragma unroll
            for (int i = 0; i < 16; ++i) { clv[i] = ptr[(size_t)i * (9216 / 4)]; glv[i] = gsum[bh * 64 + c0 + i]; mlv[i] = mloc[bh * 64 + c0 + i]; }
#pragma unroll
            for (int i = 0; i < 16; ++i) { const float gl = glv[i], ml = mlv[i]; const u32x2 cl = clv[i];
                u32x2 w; w.x = cvt_pk_bf16(s0, s1); w.y = cvt_pk_bf16(s2, s3); ptr[(size_t)i * (9216 / 4)] = w;
                if (e == 0) mprev[bh * 64 + c0 + i] = m;
                const float mn = fmaxf(gl + m, ml), sp = __expf(gl + m - mn), sl = __expf(ml - mn);
                s0 = sp * s0 + sl * bf_lo(cl.x); s1 = sp * s1 + sl * bf_hi(cl.x); s2 = sp * s2 + sl * bf_lo(cl.y); s3 = sp * s3 + sl * bf_hi(cl.y);
                m = mn; }
            ptr += 16 * (9216 / 4); }
    }
}

__device__ __forceinline__ void mlstm_pass3(const Params& p, LAS unsigned char* lds, int itp) {
    const int tid = threadIdx.x, lane = tid & 63, wave = __builtin_amdgcn_readfirstlane(tid >> 6), fr = lane & 15, fq = lane >> 4;
    const int sub = wave >> 2, hw = wave & 3, hl = tid & 255;
    const int item = 2 * itp + sub, b = item >> 9, hh = (item >> 6) & 7, c = item & 63, ts = b * 4096 + c * 64;
    LAS unsigned char* base = lds + sub * HSZ;
    LAS float* fb = (LAS float*)base; LAS float* fu = fb + 64; LAS float* fM = fb + 128; LAS float* fI = fb + 192;
    LAS bf16_t* Ks = (LAS bf16_t*)(base + 2048);
    LAS bf16_t* Vn = Ks + 64 * 72;
    LAS bf16_t* Qs = Vn + 64 * 152;
    const float* IF = (const float*)(p.ws + OFF_IF);
    const bf16_t* MQ = (const bf16_t*)(p.ws + OFF_MQ); const bf16_t* MK = (const bf16_t*)(p.ws + OFF_MK);
    bf16_t* OG = (bf16_t*)(p.ws + OFF_OG);
    const bf16_t* cst = (const bf16_t*)((unsigned char*)p.out + OUT_CST) + (size_t)item * 9216;
    float gf = 0.f, gi = 0.f, mp = 0.f;
    if (hw == 0) { gf = IF[(size_t)(ts + lane) * 16 + 8 + hh]; gi = IF[(size_t)(ts + lane) * 16 + hh]; mp = ((const float*)(p.ws + OFF_MPREV))[item]; }
    u32x4 qraw[2][4], kraw[2][4], vraw[4];
#pragma unroll
    for (int i = 0; i < 2; ++i) { const int task = hl + 256 * i, kg = task & 7, l = task >> 3;
        conv_load(MQ, ts + l, c * 64 + l, hh * 64 + kg * 8, qraw[i]); conv_load(MK, ts + l, c * 64 + l, hh * 64 + kg * 8, kraw[i]); }
    vn_load(p, ts, hh, hl, vraw);
    if (hw == 0) { float bc; gates_from(gf, lane, bc);
        const float u = gi - bc; float pm = u;
#pragma unroll
        for (int o = 1; o < 64; o <<= 1) { const float t = __shfl_up(pm, o); if (lane >= o) pm = fmaxf(pm, t); }
        const float M = fmaxf(mp, pm);
        fb[lane] = bc; fu[lane] = u * 1.44269504f; fM[lane] = M; fI[lane] = expf(mp - M); }
#pragma unroll
    for (int i = 0; i < 2; ++i) { const int task = hl + 256 * i, kg = task & 7, l = task >> 3; float qc[8], kc[8];
        conv_compute(p, qraw[i], hh * 64 + kg * 8, qc); conv_compute(p, kraw[i], 512 + hh * 64 + kg * 8, kc);
        u32x4 wq, wk;
        wq.x = cvt_pk_bf16(0.125f * silu(qc[0]), 0.125f * silu(qc[1])); wq.y = cvt_pk_bf16(0.125f * silu(qc[2]), 0.125f * silu(qc[3]));
        wq.z = cvt_pk_bf16(0.125f * silu(qc[4]), 0.125f * silu(qc[5])); wq.w = cvt_pk_bf16(0.125f * silu(qc[6]), 0.125f * silu(qc[7]));
        wk.x = cvt_pk_bf16(silu(kc[0]), silu(kc[1])); wk.y = cvt_pk_bf16(silu(kc[2]), silu(kc[3]));
        wk.z = cvt_pk_bf16(silu(kc[4]), silu(kc[5])); wk.w = cvt_pk_bf16(silu(kc[6]), silu(kc[7]));
        *(LAS u32x4*)(Qs + l * 72 + kg * 8) = wq; *(LAS u32x4*)(Ks + l * 72 + kg * 8) = wk; }
    vn_store(Vn, hl, vraw);
    __syncthreads();
    const int l = hw * 16 + fr;
    const unsigned vtr3 = (unsigned)(size_t)Vn + (unsigned)((4 * fq + ((lane & 15) >> 2)) * 304 + (lane & 3) * 8);
    bf16x8 qf[2];
#pragma unroll
    for (int ks = 0; ks < 2; ++ks) qf[ks] = *(const LAS bf16x8*)(Qs + l * 72 + ks * 32 + fq * 8);
    f32x4 sT[4];
#pragma unroll
    for (int st = 0; st < 4; ++st) { sT[st] = (f32x4){0.f, 0.f, 0.f, 0.f};
#pragma unroll
        for (int ks = 0; ks < 2; ++ks) { const bf16x8 kf = *(const LAS bf16x8*)(Ks + (st * 16 + fr) * 72 + ks * 32 + fq * 8); sT[st] = mfma16(kf, qf[ks], sT[st]); } }
    const float Ml = fM[l], Ml2 = Ml * 1.44269504f;
#pragma unroll
    for (int st = 0; st < 4; ++st) { const f32x4 uv = *(const LAS f32x4*)(fu + st * 16 + fq * 4);
#pragma unroll
        for (int r = 0; r < 4; ++r) { const int s = st * 16 + fq * 4 + r; sT[st][r] = (s <= l) ? sT[st][r] * __builtin_amdgcn_exp2f(uv[r] - Ml2) : 0.f; } }
    f32x4 ai[9], ae[9];
#pragma unroll
    for (int vt = 0; vt < 9; ++vt) { ai[vt] = (f32x4){0.f, 0.f, 0.f, 0.f}; ae[vt] = (f32x4){0.f, 0.f, 0.f, 0.f}; }
#pragma unroll
    for (int kk = 0; kk < 2; ++kk) {
        u32x4 w; w.x = cvt_pk_bf16(sT[2 * kk][0], sT[2 * kk][1]); w.y = cvt_pk_bf16(sT[2 * kk][2], sT[2 * kk][3]);
        w.z = cvt_pk_bf16(sT[2 * kk + 1][0], sT[2 * kk + 1][1]); w.w = cvt_pk_bf16(sT[2 * kk + 1][2], sT[2 * kk + 1][3]);
        const bf16x8 pf = __builtin_bit_cast(bf16x8, w);
        u32x2 tr[9][2];
        { const unsigned a = vtr3 + (unsigned)(kk * 9728);
          asm volatile("ds_read_b64_tr_b16 %0, %18\n\tds_read_b64_tr_b16 %1, %18 offset:4864\n\tds_read_b64_tr_b16 %2, %18 offset:32\n\tds_read_b64_tr_b16 %3, %18 offset:4896\n\tds_read_b64_tr_b16 %4, %18 offset:64\n\tds_read_b64_tr_b16 %5, %18 offset:4928\n\tds_read_b64_tr_b16 %6, %18 offset:96\n\tds_read_b64_tr_b16 %7, %18 offset:4960\n\tds_read_b64_tr_b16 %8, %18 offset:128\n\tds_read_b64_tr_b16 %9, %18 offset:4992\n\tds_read_b64_tr_b16 %10, %18 offset:160\n\tds_read_b64_tr_b16 %11, %18 offset:5024\n\tds_read_b64_tr_b16 %12, %18 offset:192\n\tds_read_b64_tr_b16 %13, %18 offset:5056\n\tds_read_b64_tr_b16 %14, %18 offset:224\n\tds_read_b64_tr_b16 %15, %18 offset:5088\n\tds_read_b64_tr_b16 %16, %18 offset:256\n\tds_read_b64_tr_b16 %17, %18 offset:5120\n\ts_waitcnt lgkmcnt(0)" : "=&v"(tr[0][0]), "=&v"(tr[0][1]), "=&v"(tr[1][0]), "=&v"(tr[1][1]), "=&v"(tr[2][0]), "=&v"(tr[2][1]), "=&v"(tr[3][0]), "=&v"(tr[3][1]), "=&v"(tr[4][0]), "=&v"(tr[4][1]), "=&v"(tr[5][0]), "=&v"(tr[5][1]), "=&v"(tr[6][0]), "=&v"(tr[6][1]), "=&v"(tr[7][0]), "=&v"(tr[7][1]), "=&v"(tr[8][0]), "=&v"(tr[8][1]) : "v"(a) : "memory"); }
#pragma unroll
        for (int vt = 0; vt < 9; ++vt) { u32x4 aw; aw.x = tr[vt][0].x; aw.y = tr[vt][0].y; aw.z = tr[vt][1].x; aw.w = tr[vt][1].y;
            ai[vt] = mfma16(__builtin_bit_cast(bf16x8, aw), pf, ai[vt]);
            const bf16x8 cf = *(const bf16x8*)(cst + (vt * 16 + fr) * 64 + kk * 32 + fq * 8);
            ae[vt] = mfma16(cf, qf[kk], ae[vt]); } }
    const float inter = fI[l];
#pragma unroll
    for (int vt = 0; vt < 9; ++vt) ai[vt] = ai[vt] + inter * ae[vt];
    const float den = __shfl(ai[8][0], fr);
    const float rD = 1.f / fmaxf(fabsf(den), expf(-(fb[l] + Ml)));
    float ss = 0.f;
#pragma unroll
    for (int vt = 0; vt < 8; ++vt) { ai[vt] = ai[vt] * rD; ss += (ai[vt][0] * ai[vt][0] + ai[vt][1] * ai[vt][1]) + (ai[vt][2] * ai[vt][2] + ai[vt][3] * ai[vt][3]); }
    ss += __shfl_xor(ss, 16); ss += __shfl_xor(ss, 32);
    const float rs = rsqrtf(ss * (1.f / 128.f) + 1e-6f);
#pragma unroll
    for (int vt = 0; vt < 8; ++vt) { const int v0 = vt * 16 + fq * 4; bf16_t* op = OG + (size_t)(ts + l) * 1024 + hh * 128 + v0;
        const u32x2 og = *(const u32x2*)op; const f32x4 nw = *(const f32x4*)(p.mnorm_w + hh * 128 + v0);
        u32x2 w; w.x = cvt_pk_bf16(bf_lo(og.x) * ai[vt][0] * rs * nw.x, bf_hi(og.x) * ai[vt][1] * rs * nw.y);
        w.y = cvt_pk_bf16(bf_lo(og.y) * ai[vt][2] * rs * nw.z, bf_hi(og.y) * ai[vt][3] * rs * nw.w);
        *(u32x2*)op = w; }
    __syncthreads();
}


struct PairOrder {
    StaticOrder so;
    __device__ bool next(int i, Unit& u) const { if (!so.next(i >> 1, u)) return false; if (i & 1) { u.pm += 64; u.pn += 4; } return true; }
    __device__ __forceinline__ void a_ready(const Unit&) const {}
    __device__ __forceinline__ void done(const Unit&) const {}
};
struct EpiMerge {
    static constexpr bool PERM = true, AFTER_DRAIN = false;
    const bf16_t *GA, *GM; bf16_t* Mg;
    __device__ __forceinline__ bool keep(const Unit& u) const { return u.pn < 4; }
    __device__ __forceinline__ void operator()(f32x4 (&acc)[2][2][4][2], const Unit& u, int ui, int wr, int wc, int fr, int fq) const {
        const bool first = u.pn < 4; const int pm = first ? u.pm : u.pm - 64, pn = first ? u.pn : u.pn - 4;
        const int row0 = pm * BM + wr * 64 + fr, col0 = pn * BM + wc * 32 + 8 * fq;
#pragma unroll
        for (int ai = 0; ai < 2; ++ai)
#pragma unroll
            for (int m = 0; m < 4; ++m)
#pragma unroll
                for (int bj = 0; bj < 2; ++bj) { const size_t idx = (size_t)(row0 + ai * HALF + m * 16) * 1024 + col0 + bj * HALF;
                    const u32x4 gm = *(const u32x4*)((first ? GA : GM) + idx);
                    float gmf[8] = {bf_lo(gm.x), bf_hi(gm.x), bf_lo(gm.y), bf_hi(gm.y), bf_lo(gm.z), bf_hi(gm.z), bf_lo(gm.w), bf_hi(gm.w)};
                    if (first) {
#pragma unroll
                        for (int i = 0; i < 4; ++i) { acc[ai][bj][m][0][i] *= gmf[i]; acc[ai][bj][m][1][i] *= gmf[4 + i]; } }
                    else { u32x4 w;
                        w.x = cvt_pk_bf16(acc[ai][bj][m][0][0] * gmf[0], acc[ai][bj][m][0][1] * gmf[1]); w.y = cvt_pk_bf16(acc[ai][bj][m][0][2] * gmf[2], acc[ai][bj][m][0][3] * gmf[3]);
                        w.z = cvt_pk_bf16(acc[ai][bj][m][1][0] * gmf[4], acc[ai][bj][m][1][1] * gmf[5]); w.w = cvt_pk_bf16(acc[ai][bj][m][1][2] * gmf[6], acc[ai][bj][m][1][3] * gmf[7]);
                        *(u32x4*)(Mg + idx) = w; } }
    }
};
struct EpiOut {
    static constexpr bool PERM = false, AFTER_DRAIN = false;
    const float* x; float* out;
    __device__ __forceinline__ bool keep(const Unit&) const { return false; }
    __device__ __forceinline__ void operator()(const f32x4 (&acc)[2][2][4][2], const Unit& u, int ui, int wr, int wc, int fr, int fq) const {
        const int row0 = u.pm * BM + wr * 64 + fr, col0 = u.pn * BM + wc * 32 + 4 * fq;
#pragma unroll
        for (int ai = 0; ai < 2; ++ai)
#pragma unroll
            for (int m = 0; m < 4; ++m) { const size_t ro = (size_t)(row0 + ai * HALF + m * 16) * 1024 + col0;
#pragma unroll
                for (int bj = 0; bj < 2; ++bj)
#pragma unroll
                    for (int n = 0; n < 2; ++n) { const f32x4 xv = *(const f32x4*)(x + ro + bj * HALF + n * 16); *(f32x4*)(out + ro + bj * HALF + n * 16) = acc[ai][bj][m][n] + xv; } }
    }
};

struct EpiOutNorm {
    static constexpr bool PERM = false, AFTER_DRAIN = true;
    const float* x; float* out; const float* fw; float* rowss; unsigned* pcnt;
    __device__ __forceinline__ bool keep(const Unit&) const { return false; }
    __device__ __forceinline__ void fused(f32x4 (&acc)[2][2][4][2], const Unit& u, int wr, int wc, int fr, int fq, PG8_LAS unsigned char*, int wid, int lane) const {
        const int row0 = u.pm * BM + wr * 64 + fr, col0 = u.pn * BM + wc * 32 + 4 * fq;
        float dummy = 0.f;
#pragma unroll
        for (int ai = 0; ai < 2; ++ai) { f32x4 xv[4][2][2];
#pragma unroll
            for (int m = 0; m < 4; ++m) { const size_t ro = (size_t)(row0 + ai * HALF + m * 16) * 1024 + col0;
#pragma unroll
                for (int bj = 0; bj < 2; ++bj)
#pragma unroll
                    for (int n = 0; n < 2; ++n) xv[m][bj][n] = *(const f32x4*)(x + ro + bj * HALF + n * 16); }
#pragma unroll
            for (int m = 0; m < 4; ++m) { float ss = 0.f;
#pragma unroll
                for (int bj = 0; bj < 2; ++bj)
#pragma unroll
                    for (int n = 0; n < 2; ++n) { const f32x4 v = acc[ai][bj][m][n] + xv[m][bj][n]; acc[ai][bj][m][n] = v; ss += (v.x * v.x + v.y * v.y) + (v.z * v.z + v.w * v.w); }
                ss += __shfl_xor(ss, 16); ss += __shfl_xor(ss, 32);
                if (fq == 0) dummy += __hip_atomic_fetch_add(rowss + row0 + ai * HALF + m * 16, ss, __ATOMIC_RELAXED, __HIP_MEMORY_SCOPE_AGENT); }
            __builtin_amdgcn_sched_barrier(0); }
        asm volatile("s_waitcnt vmcnt(0)" :: "v"(dummy) : "memory");
        __syncthreads();
        if (wid == 0 && lane == 0) { unsigned* cnt = pcnt + 64 * u.pm;
            (void)__hip_atomic_fetch_add(cnt, 1u, __ATOMIC_RELAXED, __HIP_MEMORY_SCOPE_AGENT);
            unsigned sp = 0;
            while (__hip_atomic_load(cnt, __ATOMIC_RELAXED, __HIP_MEMORY_SCOPE_AGENT) < 4u) { __builtin_amdgcn_s_sleep(8); if (++sp > (1u << 17)) break; } }
        __syncthreads();
        f32x4 wv[2][2];
#pragma unroll
        for (int bj = 0; bj < 2; ++bj)
#pragma unroll
            for (int n = 0; n < 2; ++n) wv[bj][n] = *(const f32x4*)(fw + col0 + bj * HALF + n * 16);
        float tot[2][4];
#pragma unroll
        for (int ai = 0; ai < 2; ++ai)
#pragma unroll
            for (int m = 0; m < 4; ++m) { tot[ai][m] = 0.f; if (fq == 0) tot[ai][m] = __hip_atomic_fetch_add(rowss + row0 + ai * HALF + m * 16, 0.0f, __ATOMIC_RELAXED, __HIP_MEMORY_SCOPE_AGENT); }
#pragma unroll
        for (int ai = 0; ai < 2; ++ai)
#pragma unroll
            for (int m = 0; m < 4; ++m) { const int row = row0 + ai * HALF + m * 16;
                const float rstd = rsqrtf(__shfl(tot[ai][m], fr) * (1.f / 1024.f) + 1e-6f);
                const size_t ro = (size_t)row * 1024 + col0;
#pragma unroll
                for (int bj = 0; bj < 2; ++bj)
#pragma unroll
                    for (int n = 0; n < 2; ++n) *(f32x4*)(out + ro + bj * HALF + n * 16) = acc[ai][bj][m][n] * rstd * wv[bj][n]; }
    }
};


#define XB_TMO      128
#define XB_XCNT(j)  (256  + 64 * (j))
#define XB_XSUB(j)  (1280 + 64 * (j))
#define XB_XGEN(j)  (2304 + 64 * (j))
#define XB_TOP      3328
#define XB_TOPGEN   3392
#define XCD_BAR_WORDS 3456
#define XB_SPIN_CAP (1u << 18)

__device__ __forceinline__ unsigned xb_ld(unsigned* p)              { return __hip_atomic_load(p, __ATOMIC_RELAXED, __HIP_MEMORY_SCOPE_AGENT); }
__device__ __forceinline__ unsigned xb_add(unsigned* p, unsigned v) { return __hip_atomic_fetch_add(p, v, __ATOMIC_RELAXED, __HIP_MEMORY_SCOPE_AGENT); }
__device__ __forceinline__ unsigned xb_xcc_id() { return (unsigned)__builtin_amdgcn_s_getreg((3 << 11) | 20) & 0xFu; }
#define XB_SPIN(cond, bar) do { unsigned _sp = 0; while (cond) { __builtin_amdgcn_s_sleep(1); \
    if ((++_sp & 255u) == 0u) { if (xb_ld(&(bar)[XB_TMO])) break; if (_sp > XB_SPIN_CAP) { atomicAdd(&(bar)[XB_TMO], 1u); break; } } } } while (0)

struct XcdBarrier {
    unsigned* bar; unsigned x;
    volatile LAS unsigned* st;
};

__device__ __forceinline__ XcdBarrier xcd_barrier_post(unsigned* bar, volatile LAS unsigned* st) {
    XcdBarrier b; b.bar = bar; b.x = xb_xcc_id(); b.st = st;
    if (threadIdx.x == 0) (void)xb_add(&bar[XB_XCNT(b.x)], 1u);
    return b;
}
__device__ __forceinline__ void xcd_barrier_complete(unsigned* bar, unsigned x, unsigned& nloc, unsigned& nx) {
    const unsigned G = gridDim.x * gridDim.y * gridDim.z;
    unsigned sum, cnt, mine, sp = 0u;
    for (;;) {
        sum = 0u; cnt = 0u; mine = 0u;
#pragma unroll
        for (unsigned j = 0; j < 16; ++j) { const unsigned c = xb_ld(&bar[XB_XCNT(j)]); sum += c; cnt += (c > 0u) ? 1u : 0u; mine = (j == x) ? c : mine; }
        if (sum == G) break;
        __builtin_amdgcn_s_sleep(1);
        if ((++sp & 255u) == 0u) { if (xb_ld(&bar[XB_TMO])) break; if (sp > XB_SPIN_CAP) { atomicAdd(&bar[XB_TMO], 1u); break; } }
    }
    nloc = mine > 0u ? mine : 1u; nx = cnt > 0u ? cnt : 1u;
}

__device__ __forceinline__ void xcd_barrier(const XcdBarrier& b) {
    asm volatile("s_waitcnt vmcnt(0)" ::: "memory");
    __syncthreads();
    if (threadIdx.x == 0) {
        unsigned* bar = b.bar;
        __builtin_amdgcn_s_waitcnt(0);
        unsigned nloc = b.st[0], nx = b.st[1];
        if (nloc == 0u) { xcd_barrier_complete(bar, b.x, nloc, nx); b.st[0] = nloc; b.st[1] = nx; }
        const unsigned old = xb_add(&bar[XB_XSUB(b.x)], 1u);
        const unsigned gen = old / nloc;
        if (old + 1u == (gen + 1u) * nloc) {
            __builtin_amdgcn_fence(__ATOMIC_RELEASE, "agent");
            asm volatile("s_waitcnt vmcnt(0)" ::: "memory");
            const unsigned og = xb_add(&bar[XB_TOP], 1u);
            const unsigned tg = og / nx;
            if (og + 1u == (tg + 1u) * nx) xb_add(&bar[XB_TOPGEN], 1u);
            else XB_SPIN(xb_ld(&bar[XB_TOPGEN]) == tg, bar);
            __builtin_amdgcn_fence(__ATOMIC_ACQUIRE, "agent");
            xb_add(&bar[XB_XGEN(b.x)], 1u);
            asm volatile("s_waitcnt vmcnt(0)" ::: "memory");
        } else {
            XB_SPIN(xb_ld(&bar[XB_XGEN(b.x)]) == gen, bar);
            __builtin_amdgcn_fence(__ATOMIC_ACQUIRE, "agent");
            asm volatile("s_waitcnt vmcnt(0)" ::: "memory");
        }
    }
    __syncthreads();
}

__global__ void __launch_bounds__(512, 2) mega(Params p) {
    extern __shared__ __attribute__((aligned(16))) unsigned char shm[];
    LAS unsigned char* lds = (LAS unsigned char*)shm;
    const int G = gridDim.x;
    volatile LAS unsigned* xbw = (volatile LAS unsigned*)(lds + 131072);
    if (threadIdx.x < 4) xbw[threadIdx.x] = 0u;
    __syncthreads();
    const XcdBarrier xb = xcd_barrier_post((unsigned*)(p.ws + OFF_BAR), xbw);
#ifndef PROBE_MASK
#define PROBE_MASK 0
#endif
    unsigned long long pt0 = PROBE_MASK ? wall_clock64() : 0ull;
#define PHASE(n) if (p.ph_lo <= (n) && (n) < p.ph_hi)
#define SEAM(n) if (PROBE_MASK) { if ((PROBE_MASK >> ((n) - 1)) & 1) { __syncthreads(); const unsigned long long pt1 = wall_clock64(); while (wall_clock64() - pt1 < pt1 - pt0) __builtin_amdgcn_s_sleep(8); } } \
    if (p.ph_lo < (n) && (n) < p.ph_hi) xcd_barrier(xb); if (PROBE_MASK) pt0 = wall_clock64();
    PHASE(0) phase0(p, lds, G);
    SEAM(1)
    PHASE(1) {
        Gemm g; g.A = (const bf16_t*)((unsigned char*)p.out + OUT_H); g.Bt = (const bf16_t*)((unsigned char*)p.out + OUT_WTIN); g.M = T_TOK; g.N = NPT; g.K = 1024;
        StaticOrder S; S.init(T_TOK, NPT, G, blockIdx.x);
        LAS float* biasl = (LAS float*)(lds + 131072 + 16);
        { const float* biasp = (const float*)(p.ws + OFF_BIASP); Unit u;
          for (int i = 0; i < BIAS_UNITS && S.next(i, u); ++i) if (threadIdx.x < 256) biasl[i * 256 + threadIdx.x] = biasp[u.pn * 256 + threadIdx.x];
          __syncthreads(); }
        Epi1 E; E.ws = p.ws; E.biasl = biasl;
        gemm_phase<Epi1, StaticOrder, true, true>(lds, g, S, E);
        if (G == 256 && blockIdx.x >= 192) square_transposes(p, lds, (blockIdx.x - 192) * 8 + (threadIdx.x >> 6), 512);
    }
    SEAM(2)
    PHASE(2) {
        for (int it = blockIdx.x; it < 512; it += G) attn_item(p, lds, it);
        for (int itp = blockIdx.x; itp < 1024; itp += G) mlstm_pass1(p, lds, itp);
    }
    SEAM(3)
    PHASE(3) mlstm_scan(p, G);
    SEAM(4)
    PHASE(4) { for (int itp = blockIdx.x; itp < 1024; itp += G) mlstm_pass3(p, lds, itp); }
    SEAM(5)
    PHASE(5) {
        Gemm g; g.A = (const bf16_t*)(p.ws + OFF_Z); g.Bt = (const bf16_t*)(p.ws + OFF_WAT); g.M = T_TOK; g.N = 1024; g.K = 1024;
        PairOrder S; S.so.init(T_TOK, 1024, G, blockIdx.x);
        EpiMerge E; E.GA = (const bf16_t*)(p.ws + OFF_GA); E.GM = (const bf16_t*)(p.ws + OFF_GM); E.Mg = (bf16_t*)(p.ws + OFF_Q);
        gemm_phase<EpiMerge, PairOrder, true, true>(lds, g, S, E);
    }
    SEAM(6)
    PHASE(6) {
        Gemm g; g.A = (const bf16_t*)(p.ws + OFF_Q); g.Bt = (const bf16_t*)(p.ws + OFF_WOT); g.M = T_TOK; g.N = 1024; g.K = 1024;
        StaticOrder S; S.init(T_TOK, 1024, G, blockIdx.x);
        if (G == 256) { EpiOutNorm E; E.x = p.x; E.out = p.out; E.fw = p.fnorm_w; E.rowss = (float*)(p.ws + OFF_ROWSS); E.pcnt = (unsigned*)(p.ws + OFF_PCNT);
            gemm_phase<EpiOutNorm, StaticOrder, false, true>(lds, g, S, E); }
        else { EpiOut E; E.x = p.x; E.out = p.out; gemm_phase<EpiOut, StaticOrder, true, true>(lds, g, S, E); }
    }
    if (G != 256) {
    SEAM(7)
    PHASE(7) {
        const int lane = threadIdx.x & 63, gw = blockIdx.x * 8 + (threadIdx.x >> 6);
        f32x4 nwv[4];
#pragma unroll
        for (int j = 0; j < 4; ++j) nwv[j] = ((const f32x4*)p.fnorm_w)[64 * j + lane];
        for (int row = gw; row < T_TOK; row += G * 32) {
            f32x4 v[4][4];
#pragma unroll
            for (int i = 0; i < 4; ++i) { const int r = row + i * G * 8;
                if (r < T_TOK) {
#pragma unroll
                    for (int j = 0; j < 4; ++j) v[i][j] = ((const f32x4*)(p.out + (size_t)r * 1024) + lane)[64 * j]; } }
#pragma unroll
            for (int i = 0; i < 4; ++i) { const int r = row + i * G * 8;
                if (r < T_TOK) { float ss = 0.f;
#pragma unroll
                    for (int j = 0; j < 4; ++j) ss += (v[i][j].x * v[i][j].x + v[i][j].y * v[i][j].y) + (v[i][j].z * v[i][j].z + v[i][j].w * v[i][j].w);
                    ss = wave_sum(ss);
                    const float rstd = rsqrtf(ss * (1.f / 1024.f) + 1e-6f);
#pragma unroll
                    for (int j = 0; j < 4; ++j) ((f32x4*)(p.out + (size_t)r * 1024) + lane)[64 * j] = v[i][j] * rstd * nwv[j]; } }
        }
    }
    }
}

extern "C" void kernel_launch(void* const* d_in, const int* in_sizes, int n_in, void* d_out, int out_size, void* d_ws, size_t ws_size, hipStream_t stream) {
    static int grid = 0;
    if (grid == 0) {
        if (n_in != 12 || out_size != T_TOK * 1024 || ws_size < WS_END) { fprintf(stderr, "kernel_launch: unexpected shapes (n_in %d out %d ws %zu)\n", n_in, out_size, ws_size); grid = -1; return; }
        int dev = 0, cus = 0, per_cu = 0;
        (void)hipGetDevice(&dev); (void)hipDeviceGetAttribute(&cus, hipDeviceAttributeMultiprocessorCount, dev);
        if (hipFuncSetAttribute((const void*)mega, hipFuncAttributeMaxDynamicSharedMemorySize, LDS_BYTES) != hipSuccess) { fprintf(stderr, "kernel_launch: hipFuncSetAttribute failed\n"); grid = -1; return; }
        if (hipOccupancyMaxActiveBlocksPerMultiprocessor(&per_cu, (const void*)mega, 512, LDS_BYTES) != hipSuccess || per_cu < 1) { fprintf(stderr, "kernel_launch: occupancy query failed (%d)\n", per_cu); grid = -1; return; }
        grid = cus * per_cu;
    }
    if (grid < 0) return;
    if (hipMemsetAsync((char*)d_ws + OFF_BAR, 0, (size_t)(OFF_ROWSS + 65536 - OFF_BAR), stream) != hipSuccess) { fprintf(stderr, "kernel_launch: memset failed\n"); return; }
    Params p{};
    p.x = (const float*)d_in[0]; p.norm_w = (const float*)d_in[1]; p.w_in = (const float*)d_in[2]; p.b_in = (const float*)d_in[3]; p.sinks = (const float*)d_in[4];
    p.conv_w = (const float*)d_in[5]; p.conv_b = (const float*)d_in[6]; p.mnorm_w = (const float*)d_in[7]; p.w_ba = (const float*)d_in[8]; p.w_bm = (const float*)d_in[9];
    p.w_out = (const float*)d_in[10]; p.fnorm_w = (const float*)d_in[11];
    p.out = (float*)d_out; p.ws = (unsigned char*)d_ws; p.ph_lo = 0; p.ph_hi = 8;
    void* args[] = {&p};
    hipError_t e = hipLaunchCooperativeKernel((const void*)mega, dim3(grid), dim3(512), args, LDS_BYTES, stream);
    if (e != hipSuccess) fprintf(stderr, "kernel_launch: cooperative launch failed: %s (grid %d)\n", hipGetErrorString(e), grid);
}
```

```cpp
#include <hip/hip_runtime.h>
#include <cstdio>
#include <cmath>
namespace pg8 {
#define PG8_LAS __attribute__((address_space(3)))
typedef unsigned short bf16_t;
typedef short bf16x8 __attribute__((ext_vector_type(8)));
typedef float f32x4 __attribute__((ext_vector_type(4)));
typedef unsigned u32x4 __attribute__((ext_vector_type(4)));
constexpr int BM = 256, BK = 64, HALF = 128, HTB = HALF * BK * 2  , STAGE_BYTES = 8 * HTB, NXCD = 8, WGM = 8;

__host__ __device__ __forceinline__ int lds_byte(int r, int c) { const int st = (r >> 4) * 2 + (c >> 5), rr = r & 15, cc = c & 31, ob = rr * 64 + cc * 2; return st * 1024 + (ob ^ (((ob >> 9) & 1) << 5)); }
__host__ __device__ __forceinline__ void stage_rc(int b, int& R, int& C) { const int st = b / 1024, sb = b % 1024, swz = sb ^ (((sb >> 9) & 1) << 5); R = (st >> 1) * 16 + swz / 64; C = (st & 1) * 32 + (swz % 64) / 2; }
__host__ __device__ __forceinline__ int perm32(int rho) { const int n = rho >> 4, i = rho & 15; return 8 * (i >> 2) + 4 * n + (i & 3); }

struct Unit { int pm, pn; };
struct Gemm { const bf16_t* A; const bf16_t* Bt; int M, N, K; };

struct StaticOrder {
    int nM, nN, nwg, G, c;
    __host__ __device__ void init(int M, int N, int G_, int c_) { nM = M / BM; nN = N / BM; nwg = nM * nN; G = G_; c = c_; }
    __host__ __device__ bool next(int i, Unit& u) const {
        const long L = (long)i * G + c; if (L >= nwg) return false;
        int wgid = (int)L; { const int q = nwg / NXCD, r = nwg % NXCD, xcd = wgid % NXCD, off = wgid / NXCD; wgid = (xcd < r ? xcd * (q + 1) : r * (q + 1) + (xcd - r) * q) + off; }
        const int nig = WGM * nN, gid = wgid / nig, fm = gid * WGM, gsz = (nM - fm) < WGM ? (nM - fm) : WGM;
        u.pm = fm + ((wgid % nig) % gsz); u.pn = (wgid % nig) / gsz; return true;
    }
    __device__ __forceinline__ void a_ready(const Unit&) const {}
    __device__ __forceinline__ void done(const Unit&) const {}
};
__device__ __forceinline__ unsigned cvt_pk_bf16(float lo, float hi) { unsigned r; asm volatile("v_cvt_pk_bf16_f32 %0, %1, %2" : "=v"(r) : "v"(lo), "v"(hi)); return r; }
template <class Epi, class Sched, bool ALIGN_EPI = false, bool SP2 = false>
__device__ __forceinline__ void gemm_phase(PG8_LAS unsigned char* lds, const Gemm g, const Sched& S, const Epi& E) {
    const int tid = threadIdx.x, wid = __builtin_amdgcn_readfirstlane(tid >> 6), lane = tid & 63, wr = wid >> 2, wc = wid & 3, fr = lane & 15, fq = lane >> 4;
    const int K = g.K, nt = K / BK;
    unsigned voffA[2], voffB[2];
#pragma unroll
    for (int i = 0; i < 2; ++i) { int R, C; stage_rc(tid * 16 + i * 8192, R, C); const int Rb = Epi::PERM ? ((R & ~31) + perm32(R & 31)) : R;
        voffA[i] = (unsigned)(R * K + C) * 2u; voffB[i] = (unsigned)(Rb * K + C) * 2u; }
    const size_t kstep = (size_t)(BK * 2);
    const size_t hstep = (size_t)HALF * K * 2;
    const size_t tstep = 2 * hstep;
    const unsigned ldsw = (unsigned)wid * 1024u;
    const int aoff = lds_byte(wr * 64 + fr, fq * 8), boff = lds_byte(wc * 32 + fr, fq * 8);
#define PG8_SA(b, h) (((b) * 2 + (h)) * HTB)
#define PG8_SB(b, h) ((4 + (b) * 2 + (h)) * HTB)
#define PG8_STAGE(bufoff, gbase, voff) do { _Pragma("unroll") for (int _i = 0; _i < 2; ++_i) \
        __builtin_amdgcn_global_load_lds((const unsigned*)((const char*)(gbase) + (voff)[_i]), (PG8_LAS unsigned*)(lds + (bufoff) + ldsw + _i * 8192), 16, 0, 0); } while (0)
#define PG8_LDA(dst, b, h) do { _Pragma("unroll") for (int m = 0; m < 4; ++m) _Pragma("unroll") for (int k = 0; k < 2; ++k) dst[m][k] = *(const PG8_LAS bf16x8*)(lds + PG8_SA(b, h) + aoff + m * 2048 + k * 1024); } while (0)
#define PG8_LDB(dst, b, h) do { _Pragma("unroll") for (int n = 0; n < 2; ++n) _Pragma("unroll") for (int k = 0; k < 2; ++k) dst[n][k] = *(const PG8_LAS bf16x8*)(lds + PG8_SB(b, h) + boff + n * 2048 + k * 1024); } while (0)
#define PG8_MMA(ai, bj, At, Bt) do { __builtin_amdgcn_s_setprio(1); _Pragma("unroll") for (int m = 0; m < 4; ++m) _Pragma("unroll") for (int n = 0; n < 2; ++n) _Pragma("unroll") for (int k = 0; k < 2; ++k) \
        acc[ai][bj][m][n] = __builtin_amdgcn_mfma_f32_16x16x32_bf16(Bt[n][k], At[m][k], acc[ai][bj][m][n], 0, 0, 0); __builtin_amdgcn_s_setprio(0); } while (0)
#define PG8_WAIT_V(n) asm volatile("s_waitcnt vmcnt(" #n ")" ::: "memory")
#define PG8_WAIT_L(n) asm volatile("s_waitcnt lgkmcnt(" #n ")" ::: "memory")
#define PG8_BAR __builtin_amdgcn_s_barrier()
#define PG8_SCHED __builtin_amdgcn_sched_barrier(0)
    Unit cur, nxt; int ui = 0;
    if (!S.next(0, cur)) return;
    f32x4 acc[2][2][4][2];
#pragma unroll
    for (int a = 0; a < 2; ++a)
#pragma unroll
        for (int b = 0; b < 2; ++b)
#pragma unroll
            for (int m = 0; m < 4; ++m)
#pragma unroll
                for (int n = 0; n < 2; ++n) acc[a][b][m][n] = (f32x4){0.f, 0.f, 0.f, 0.f};
    bf16x8 At[4][2], B0[2][2], B1[2][2];
    const char* cA = (const char*)g.A + (size_t)cur.pm * tstep; const char* cB = (const char*)g.Bt + (size_t)cur.pn * tstep;
    S.a_ready(cur);
    if constexpr (SP2) {
        PG8_STAGE(PG8_SB(0, 0), cB, voffB); PG8_STAGE(PG8_SB(0, 1), cB + hstep, voffB); PG8_STAGE(PG8_SA(0, 0), cA, voffA); PG8_STAGE(PG8_SA(0, 1), cA + hstep, voffA);
        if (wr == 1) PG8_BAR;
        PG8_WAIT_V(2); PG8_BAR;
        PG8_STAGE(PG8_SB(1, 0), cB + kstep, voffB); PG8_STAGE(PG8_SA(1, 0), cA + kstep, voffA); PG8_STAGE(PG8_SB(1, 1), cB + hstep + kstep, voffB);
        PG8_WAIT_V(6); PG8_BAR;
    } else {
        PG8_STAGE(PG8_SB(0, 0), cB, voffB); PG8_STAGE(PG8_SA(0, 0), cA, voffA); PG8_STAGE(PG8_SB(0, 1), cB + hstep, voffB); PG8_STAGE(PG8_SA(0, 1), cA + hstep, voffA);
        if (wr == 1) PG8_BAR;
        PG8_WAIT_V(4); PG8_BAR;
        PG8_STAGE(PG8_SB(1, 0), cB + kstep, voffB); PG8_STAGE(PG8_SA(1, 0), cA + kstep, voffA); PG8_STAGE(PG8_SB(1, 1), cB + hstep + kstep, voffB);
        PG8_WAIT_V(6); PG8_BAR;
    }
    for (;;) {
        const bool has_next = S.next(ui + 1, nxt);
        const char* nA = has_next ? (const char*)g.A + (size_t)nxt.pm * tstep : cA; const char* nB = has_next ? (const char*)g.Bt + (size_t)nxt.pn * tstep : cB;
        for (int t = 0; t < nt; t += 2) {
            const bool last = (t == nt - 2);
            const char* a1 = cA + (size_t)(t + 1) * kstep;
            const char* a2 = last ? nA : cA + (size_t)(t + 2) * kstep; const char* b2 = last ? nB : cB + (size_t)(t + 2) * kstep;
            const char* a3 = a2 + kstep; const char* b3 = b2 + kstep;
            if (last && has_next) S.a_ready(nxt);
            if constexpr (SP2) {
            PG8_LDB(B0, 0, 0); PG8_LDB(B1, 0, 1); PG8_SCHED; PG8_LDA(At, 0, 0); PG8_STAGE(PG8_SA(1, 1), a1 + hstep, voffA);
            PG8_WAIT_V(8); PG8_WAIT_L(0); PG8_BAR; PG8_MMA(0, 0, At, B0); PG8_MMA(0, 1, At, B1); PG8_BAR; PG8_SCHED;
            PG8_LDA(At, 0, 1); PG8_STAGE(PG8_SB(0, 0), b2, voffB); PG8_STAGE(PG8_SB(0, 1), b2 + hstep, voffB); PG8_STAGE(PG8_SA(0, 0), a2, voffA);
            PG8_WAIT_V(8); PG8_WAIT_L(0); PG8_BAR; PG8_MMA(1, 0, At, B0); PG8_MMA(1, 1, At, B1); PG8_BAR; PG8_SCHED;
            PG8_LDB(B0, 1, 0); PG8_LDB(B1, 1, 1); PG8_SCHED; PG8_LDA(At, 1, 0); PG8_STAGE(PG8_SA(0, 1), a2 + hstep, voffA);
            PG8_WAIT_V(8); PG8_WAIT_L(0); PG8_BAR; PG8_MMA(0, 0, At, B0); PG8_MMA(0, 1, At, B1); PG8_BAR; PG8_SCHED;
            PG8_LDA(At, 1, 1); PG8_STAGE(PG8_SB(1, 0), b3, voffB); PG8_STAGE(PG8_SB(1, 1), b3 + hstep, voffB); PG8_STAGE(PG8_SA(1, 0), a3, voffA);
            PG8_WAIT_V(8); PG8_WAIT_L(0); PG8_BAR; PG8_MMA(1, 0, At, B0); PG8_MMA(1, 1, At, B1); PG8_BAR; PG8_SCHED;
            } else {
            PG8_LDB(B0, 0, 0); PG8_SCHED; PG8_LDA(At, 0, 0); PG8_STAGE(PG8_SA(1, 1), a1 + hstep, voffA);
            PG8_WAIT_L(8); PG8_BAR; PG8_WAIT_L(0); PG8_MMA(0, 0, At, B0); PG8_BAR; PG8_SCHED;
            PG8_LDB(B1, 0, 1); PG8_STAGE(PG8_SB(0, 0), b2, voffB);
            PG8_BAR; PG8_WAIT_L(0); PG8_MMA(0, 1, At, B1); PG8_BAR;
            PG8_LDA(At, 0, 1); PG8_STAGE(PG8_SA(0, 0), a2, voffA);
            PG8_BAR; PG8_WAIT_L(0); PG8_MMA(1, 0, At, B0); PG8_BAR; PG8_SCHED;
            PG8_STAGE(PG8_SB(0, 1), b2 + hstep, voffB);
            PG8_WAIT_V(6); PG8_BAR; PG8_MMA(1, 1, At, B1); PG8_BAR;
            PG8_LDB(B0, 1, 0); PG8_SCHED; PG8_LDA(At, 1, 0); PG8_STAGE(PG8_SA(0, 1), a2 + hstep, voffA);
            PG8_WAIT_L(8); PG8_BAR; PG8_WAIT_L(0); PG8_MMA(0, 0, At, B0); PG8_BAR; PG8_SCHED;
            PG8_LDB(B1, 1, 1); PG8_STAGE(PG8_SB(1, 0), b3, voffB);
            PG8_BAR; PG8_WAIT_L(0); PG8_MMA(0, 1, At, B1); PG8_BAR;
            PG8_LDA(At, 1, 1); PG8_STAGE(PG8_SA(1, 0), a3, voffA);
            PG8_BAR; PG8_WAIT_L(0); PG8_MMA(1, 0, At, B0); PG8_BAR; PG8_SCHED;
            PG8_STAGE(PG8_SB(1, 1), b3 + hstep, voffB);
            PG8_WAIT_V(6); PG8_BAR; PG8_MMA(1, 1, At, B1); PG8_BAR;
            }
        }
        if constexpr (ALIGN_EPI) { if (wr == 0) PG8_BAR; }
        if constexpr (!Epi::AFTER_DRAIN) { E(acc, cur, ui, wr, wc, fr, fq); S.done(cur); }
        if (!has_next) break;
        if (!E.keep(cur))
#pragma unroll
        for (int a = 0; a < 2; ++a)
#pragma unroll
            for (int b = 0; b < 2; ++b)
#pragma unroll
                for (int m = 0; m < 4; ++m)
#pragma unroll
                    for (int n = 0; n < 2; ++n) acc[a][b][m][n] = (f32x4){0.f, 0.f, 0.f, 0.f};
        cur = nxt; cA = nA; cB = nB; ++ui;
        if constexpr (ALIGN_EPI) { if (wr == 1) PG8_BAR; }
    }
    PG8_WAIT_V(0);
    if constexpr (!ALIGN_EPI) { if (wr == 0) PG8_BAR; }
    PG8_BAR;
    if constexpr (Epi::AFTER_DRAIN) { E.fused(acc, cur, wr, wc, fr, fq, lds, wid, lane); S.done(cur); }
#undef PG8_SA
#undef PG8_SB
#undef PG8_STAGE
#undef PG8_LDA
#undef PG8_LDB
#undef PG8_MMA
#undef PG8_WAIT_V
#undef PG8_WAIT_L
#undef PG8_BAR
#undef PG8_SCHED
}
}

using namespace pg8;
#define LAS __attribute__((address_space(3)))
typedef unsigned u32x2 __attribute__((ext_vector_type(2)));

constexpr int T_TOK = 16384, PROJ = 8720, NP = 8704, NPT = 8960;
constexpr size_t MiB = 1ull << 20;
constexpr size_t OFF_Q = 0, OFF_Z = 32 * MiB, OFF_OG = 64 * MiB, OFF_GA = 96 * MiB, OFF_GM = 128 * MiB, OFF_MV = 160 * MiB,
                 OFF_MQ = 192 * MiB, OFF_MK = 208 * MiB, OFF_K = 224 * MiB, OFF_V = 232 * MiB, OFF_WAT = 240 * MiB,
                 OFF_WOT = 244 * MiB, OFF_IF = 246 * MiB, OFF_BIASP = 247 * MiB, OFF_MLOC = OFF_BIASP + 65536,
                 OFF_GSUM = OFF_MLOC + 8192, OFF_MPREV = OFF_GSUM + 8192, OFF_BAR = OFF_MPREV + 8192, OFF_PCNT = OFF_BAR + 16384, OFF_ROWSS = OFF_PCNT + 16384, WS_END = OFF_ROWSS + 65536;
constexpr size_t OFF_GPRE = 248 * MiB;
constexpr size_t OUT_H = 0, OUT_WTIN = 32 * MiB, OUT_CST = 0;
constexpr int BIAS_UNITS = 12;
constexpr int LDS_BYTES = 131072 + 16 + BIAS_UNITS * 1024;
constexpr int HSZ = 49408;

struct Params {
    const float *x, *norm_w, *w_in, *b_in, *sinks, *conv_w, *conv_b, *mnorm_w, *w_ba, *w_bm, *w_out, *fnorm_w;
    float* out; unsigned char* ws;
    int ph_lo, ph_hi;
};

__device__ __forceinline__ float bf_lo(unsigned w) { return __uint_as_float(w << 16); }
__device__ __forceinline__ float bf_hi(unsigned w) { return __uint_as_float(w & 0xffff0000u); }
__device__ __forceinline__ float bf2f(bf16_t b) { return __uint_as_float(((unsigned)b) << 16); }
__device__ __forceinline__ bf16_t f2bf(float f) { unsigned u = __float_as_uint(f); u += 0x7fffu + ((u >> 16) & 1u); return (bf16_t)(u >> 16); }
__device__ __forceinline__ float sigm(float x) { return __builtin_amdgcn_rcpf(1.f + __builtin_amdgcn_exp2f(-1.44269504f * x)); }
__device__ __forceinline__ float silu(float x) { return x * __builtin_amdgcn_rcpf(1.f + __builtin_amdgcn_exp2f(-1.44269504f * x)); }
__device__ __forceinline__ float wave_sum(float v) {
#pragma unroll
    for (int o = 1; o < 64; o <<= 1) v += __shfl_xor(v, o);
    return v;
}
__device__ __forceinline__ float wave_max(float v) {
#pragma unroll
    for (int o = 1; o < 64; o <<= 1) v = fmaxf(v, __shfl_xor(v, o));
    return v;
}
__device__ __forceinline__ f32x4 mfma16(bf16x8 a, bf16x8 b, f32x4 c) { return __builtin_amdgcn_mfma_f32_16x16x32_bf16(a, b, c, 0, 0, 0); }

__device__ __forceinline__ int src_col(int np) {
    if (np < 4608) return np;
    if (np < 6656) { const int t = (np - 4608) >> 8, r = np & 255; return (r < 128) ? (4624 + 128 * t + r) : (5648 + 128 * t + (r - 128)); }
    if (np >= 8704) return 4608 + (np - 8704);
    { const int t = (np - 6656) >> 8, r = np & 255; return (r < 128) ? (6672 + 128 * t + r) : (7696 + 128 * t + (r - 128)); }
}

__device__ __forceinline__ void transpose_item(const float* W, int N, int n_src0, bf16_t* WT, int row0, int k0, LAS float* scr, int lane) {
    f32x4 tv[8]; const int kr = lane >> 3, nc = (lane & 7) * 4;
#pragma unroll
    for (int i = 0; i < 8; ++i) tv[i] = __builtin_nontemporal_load((const f32x4*)(W + (size_t)(k0 + kr + 8 * i) * N + n_src0 + nc));
#pragma unroll
    for (int i = 0; i < 8; ++i) { LAS float* d = scr + (kr + 8 * i) * 33 + nc; d[0] = tv[i].x; d[1] = tv[i].y; d[2] = tv[i].z; d[3] = tv[i].w; }
    asm volatile("s_waitcnt lgkmcnt(0)" ::: "memory");
    const int c = lane & 7;
#pragma unroll
    for (int j = 0; j < 4; ++j) { const int n = (lane >> 3) + 8 * j; const LAS float* s = scr + (8 * c) * 33 + n;
        u32x4 o; o.x = cvt_pk_bf16(s[0], s[33]); o.y = cvt_pk_bf16(s[66], s[99]); o.z = cvt_pk_bf16(s[132], s[165]); o.w = cvt_pk_bf16(s[198], s[231]);
        *(u32x4*)(WT + (size_t)(row0 + n) * 1024 + k0 + 8 * c) = o; }
    asm volatile("s_waitcnt lgkmcnt(0)" ::: "memory");
}

__device__ __forceinline__ void square_transposes(const Params& p, LAS unsigned char* lds, int widx, int nw) {
    const int lane = threadIdx.x & 63, wave = threadIdx.x >> 6;
    bf16_t* WaT = (bf16_t*)(p.ws + OFF_WAT); bf16_t* WoT = (bf16_t*)(p.ws + OFF_WOT);
    LAS float* scr = (LAS float*)lds + wave * (64 * 33);
    constexpr int I_SQ = 16 * 32;
    for (int it = widx; it < 3 * I_SQ; it += nw) { int r = it; const int mtx = r / I_SQ; r %= I_SQ; const int kb = r / 32, nb = r % 32;
        const float* W = mtx == 0 ? p.w_ba : (mtx == 1 ? p.w_bm : p.w_out);
        bf16_t* WT = mtx == 2 ? WoT : WaT; const int row0 = (mtx == 1 ? 1024 : 0) + nb * 32;
        transpose_item(W, 1024, nb * 32, WT, row0, kb * 64, scr, lane); }
}
__device__ __forceinline__ void phase0(const Params& p, LAS unsigned char* lds, int G) {
    const int tid = threadIdx.x, lane = tid & 63, wave = tid >> 6;
    const int gw = blockIdx.x * 8 + wave, NGW = G * 8;
    bf16_t* WtIn = (bf16_t*)((unsigned char*)p.out + OUT_WTIN);
    bf16_t* WaT = (bf16_t*)(p.ws + OFF_WAT);
    bf16_t* WoT = (bf16_t*)(p.ws + OFF_WOT);
    LAS float* scr = (LAS float*)lds + wave * (64 * 33);
    constexpr int NBLK = NP / 32 + 1, I_IN = 16 * NBLK, I_SQ = 16 * 32;
    for (int it = gw; it < I_IN; it += NGW) { const int kb = it / NBLK, nb = it % NBLK; transpose_item(p.w_in, PROJ, src_col(nb * 32), WtIn, nb * 32, kb * 64, scr, lane); }
    if (G != 256) square_transposes(p, lds, gw, NGW);
    float* biasp = (float*)(p.ws + OFF_BIASP);
    for (int i = blockIdx.x * 512 + tid; i < NP + 32; i += G * 512) biasp[i] = p.b_in[src_col(i)];
    bf16_t* H = (bf16_t*)((unsigned char*)p.out + OUT_H);
    f32x4 nwv[4], nxt[4];
#pragma unroll
    for (int j = 0; j < 4; ++j) { nwv[j] = ((const f32x4*)p.norm_w)[64 * j + lane]; nxt[j] = __builtin_nontemporal_load((const f32x4*)(p.x + (size_t)gw * 1024) + lane + 64 * j); }
    for (int row = gw; row < T_TOK; row += NGW) {
        f32x4 v[4]; float ss = 0.f;
#pragma unroll
        for (int j = 0; j < 4; ++j) v[j] = nxt[j];
        if (row + NGW < T_TOK) {
#pragma unroll
            for (int j = 0; j < 4; ++j) nxt[j] = __builtin_nontemporal_load((const f32x4*)(p.x + (size_t)(row + NGW) * 1024) + lane + 64 * j); }
#pragma unroll
        for (int j = 0; j < 4; ++j) ss += (v[j].x * v[j].x + v[j].y * v[j].y) + (v[j].z * v[j].z + v[j].w * v[j].w);
        ss = wave_sum(ss);
        const float rstd = rsqrtf(ss * (1.f / 1024.f) + 1e-6f);
#pragma unroll
        for (int j = 0; j < 4; ++j) { const f32x4 nw = nwv[j]; v[j] = v[j] * rstd * nw;
            u32x2 o; o.x = cvt_pk_bf16(v[j].x, v[j].y); o.y = cvt_pk_bf16(v[j].z, v[j].w);
            *((u32x2*)(H + (size_t)row * 1024) + 64 * j + lane) = o; }
    }
}

struct Epi1 {
    static constexpr bool PERM = true, AFTER_DRAIN = false;
    unsigned char* ws; const LAS float* biasl;
    __device__ __forceinline__ bool keep(const Unit&) const { return false; }
    __device__ __forceinline__ void operator()(const f32x4 (&acc)[2][2][4][2], const Unit& u, int ui, int wr, int wc, int fr, int fq) const {
        const int pn = u.pn, row0 = u.pm * BM + wr * 64 + fr, lc = wc * 32 + 8 * fq;
        f32x4 bv[2][2];
#pragma unroll
        for (int bj = 0; bj < 2; ++bj)
#pragma unroll
            for (int n = 0; n < 2; ++n) bv[bj][n] = *(const LAS f32x4*)(biasl + ui * 256 + bj * HALF + lc + 4 * n);
        if (pn == 34) {
            if (wc == 0 && fq < 2) { float* IF = (float*)(ws + OFF_IF);
#pragma unroll
                for (int ai = 0; ai < 2; ++ai)
#pragma unroll
                    for (int m = 0; m < 4; ++m) { float* gp = IF + (size_t)(row0 + ai * HALF + m * 16) * 16 + 8 * fq;
                        *(f32x4*)gp = acc[ai][0][m][0] + bv[0][0]; *(f32x4*)(gp + 4) = acc[ai][0][m][1] + bv[0][1]; } }
            return;
        }
        if (pn >= 26) {
            bf16_t* RA = (bf16_t*)(ws + OFF_GA); bf16_t* GMb = (bf16_t*)(ws + OFF_GM); const int cb = (pn - 26) * 128 + lc;
#pragma unroll
            for (int ai = 0; ai < 2; ++ai)
#pragma unroll
                for (int m = 0; m < 4; ++m) { float ra[8], gm[8];
#pragma unroll
                    for (int n = 0; n < 2; ++n)
#pragma unroll
                        for (int i = 0; i < 4; ++i) { const float a = acc[ai][0][m][n][i] + bv[0][n][i], b = acc[ai][1][m][n][i] + bv[1][n][i];
                            const float da = 1.f + __builtin_amdgcn_exp2f(-1.44269504f * a), db = 1.f + __builtin_amdgcn_exp2f(-1.44269504f * b);
                            ra[4 * n + i] = db * __builtin_amdgcn_rcpf(da); gm[4 * n + i] = __builtin_amdgcn_rcpf(db); }
                    u32x4 w; w.x = cvt_pk_bf16(ra[0], ra[1]); w.y = cvt_pk_bf16(ra[2], ra[3]); w.z = cvt_pk_bf16(ra[4], ra[5]); w.w = cvt_pk_bf16(ra[6], ra[7]);
                    const size_t o = (size_t)(row0 + ai * HALF + m * 16) * 1024 + cb;
                    *(u32x4*)(RA + o) = w;
                    w.x = cvt_pk_bf16(gm[0], gm[1]); w.y = cvt_pk_bf16(gm[2], gm[3]); w.z = cvt_pk_bf16(gm[4], gm[5]); w.w = cvt_pk_bf16(gm[6], gm[7]);
                    *(u32x4*)(GMb + o) = w; }
            return;
        }
        if (pn >= 18 && pn < 26) {
            bf16_t* OG = (bf16_t*)(ws + OFF_OG); const int cb = (pn - 18) * 128 + lc;
#pragma unroll
            for (int ai = 0; ai < 2; ++ai)
#pragma unroll
                for (int m = 0; m < 4; ++m) { float r[8];
#pragma unroll
                    for (int n = 0; n < 2; ++n)
#pragma unroll
                        for (int i = 0; i < 4; ++i) { const float o = acc[ai][0][m][n][i] + bv[0][n][i], z = acc[ai][1][m][n][i] + bv[1][n][i]; r[4 * n + i] = sigm(o) * silu(z); }
                    u32x4 w; w.x = cvt_pk_bf16(r[0], r[1]); w.y = cvt_pk_bf16(r[2], r[3]); w.z = cvt_pk_bf16(r[4], r[5]); w.w = cvt_pk_bf16(r[6], r[7]);
                    *(u32x4*)(OG + (size_t)(row0 + ai * HALF + m * 16) * 1024 + cb) = w; }
            return;
        }
        size_t off; int ld, c0, act;
        if (pn < 4) { off = OFF_Q; ld = 1024; c0 = pn * 256; act = 1; }
        else if (pn == 4) { off = OFF_K; ld = 256; c0 = 0; act = 0; }
        else if (pn == 5) { off = OFF_V; ld = 256; c0 = 0; act = 0; }
        else if (pn < 10) { off = OFF_Z; ld = 1024; c0 = (pn - 6) * 256; act = 2; }
        else if (pn < 12) { off = OFF_MQ; ld = 512; c0 = (pn - 10) * 256; act = 0; }
        else if (pn < 14) { off = OFF_MK; ld = 512; c0 = (pn - 12) * 256; act = 0; }
        else { off = OFF_MV; ld = 1024; c0 = (pn - 14) * 256; act = 0; }
        bf16_t* dst = (bf16_t*)(ws + off) + c0 + lc;
#pragma unroll
        for (int ai = 0; ai < 2; ++ai)
#pragma unroll
            for (int m = 0; m < 4; ++m) { bf16_t* rowp = dst + (size_t)(row0 + ai * HALF + m * 16) * ld;
#pragma unroll
                for (int bj = 0; bj < 2; ++bj) { f32x4 v0 = acc[ai][bj][m][0] + bv[bj][0], v1 = acc[ai][bj][m][1] + bv[bj][1];
                    if (act == 1) { v0 = v0 * 0.18033688f; v1 = v1 * 0.18033688f; }
                    else if (act == 2) {
#pragma unroll
                        for (int i = 0; i < 4; ++i) { v0[i] = silu(v0[i]); v1[i] = silu(v1[i]); } }
                    else if (act == 3) {
#pragma unroll
                        for (int i = 0; i < 4; ++i) { v0[i] = sigm(v0[i]); v1[i] = sigm(v1[i]); } }
                    u32x4 w; w.x = cvt_pk_bf16(v0[0], v0[1]); w.y = cvt_pk_bf16(v0[2], v0[3]); w.z = cvt_pk_bf16(v1[0], v1[1]); w.w = cvt_pk_bf16(v1[2], v1[3]);
                    *(u32x4*)(rowp + bj * HALF) = w; } }
    }
};

__device__ __forceinline__ void attn_item(const Params& p, LAS unsigned char* lds, int it) {
    const int tid = threadIdx.x, lane = tid & 63, wave = tid >> 6, fr = lane & 15, fq = lane >> 4;
    const int b = it >> 7, kvh = (it >> 5) & 3, qb = it & 31, t0 = b * 4096 + qb * 128;
    LAS bf16_t* Ks = (LAS bf16_t*)lds;
    LAS bf16_t* Vs = Ks + 256 * 72;
    const bf16_t* Kb = (const bf16_t*)(p.ws + OFF_K); const bf16_t* Vb = (const bf16_t*)(p.ws + OFF_V);
    const bf16_t* Q = (const bf16_t*)(p.ws + OFF_Q); bf16_t* Z = (bf16_t*)(p.ws + OFF_Z);
    const unsigned vtr_base = (unsigned)(size_t)Vs + (unsigned)((4 * fq + ((lane & 15) >> 2)) * 144 + (lane & 3) * 8);
    const int g = wave & 3, half = wave >> 2, hq = kvh * 4 + g; const float sink = p.sinks[hq] * 1.44269504f; const int dlt = fq * 4 - fr;
    u32x4 kraw[4], vraw[4];
#pragma unroll
    for (int i = 0; i < 4; ++i) { const int c = tid + 512 * i, sj = c >> 3, dc = c & 7; kraw[i] = (u32x4){0u, 0u, 0u, 0u}; vraw[i] = (u32x4){0u, 0u, 0u, 0u};
        if (qb > 0 || sj >= 128) { const size_t off = (size_t)(t0 - 128 + sj) * 256 + kvh * 64 + dc * 8; kraw[i] = *(const u32x4*)(Kb + off); vraw[i] = *(const u32x4*)(Vb + off); } }
    bf16x8 qf[2][2][2]; u32x2 zz[2][2][4];
#pragma unroll
    for (int qc = 0; qc < 2; ++qc)
#pragma unroll
        for (int qs = 0; qs < 2; ++qs) { const size_t ro = (size_t)(t0 + half * 64 + qc * 32 + qs * 16 + fr) * 1024 + hq * 64;
#pragma unroll
            for (int ks = 0; ks < 2; ++ks) qf[qc][qs][ks] = *(const bf16x8*)(Q + ro + ks * 32 + fq * 8);
#pragma unroll
            for (int dt = 0; dt < 4; ++dt) zz[qc][qs][dt] = *(const u32x2*)(Z + ro + dt * 16 + fq * 4); }
#pragma unroll
    for (int i = 0; i < 4; ++i) { const int c = tid + 512 * i, sj = c >> 3, dc = c & 7;
        *(LAS u32x4*)(Ks + sj * 72 + dc * 8) = kraw[i]; *(LAS u32x4*)(Vs + sj * 72 + dc * 8) = vraw[i]; }
    __syncthreads();
#pragma unroll
    for (int qc = 0; qc < 2; ++qc) {
        const int i0 = half * 64 + qc * 32;
        f32x4 s[10][2];
#pragma unroll
        for (int kt = 0; kt < 10; ++kt) { s[kt][0] = (f32x4){0.f, 0.f, 0.f, 0.f}; s[kt][1] = (f32x4){0.f, 0.f, 0.f, 0.f};
#pragma unroll
            for (int ks = 0; ks < 2; ++ks) { const bf16x8 kf = *(const LAS bf16x8*)(Ks + (i0 + kt * 16 + fr) * 72 + ks * 32 + fq * 8);
                s[kt][0] = mfma16(kf, qf[qc][0][ks], s[kt][0]); s[kt][1] = mfma16(kf, qf[qc][1][ks], s[kt][1]); } }
        float mx[2] = {sink, sink};
        const int lowtile = (qb == 0) ? ((128 - i0) >> 4) : 0;
#pragma unroll
        for (int kt = 0; kt < 10; ++kt) {
            if (kt < lowtile) { s[kt][0] = (f32x4){-INFINITY, -INFINITY, -INFINITY, -INFINITY}; s[kt][1] = s[kt][0]; }
#pragma unroll
            for (int qs = 0; qs < 2; ++qs)
#pragma unroll
                for (int r = 0; r < 4; ++r) { float sv = s[kt][qs][r];
                    if (kt - qs <= 0) sv = ((kt - qs) * 16 + r + dlt > 0) ? sv : -INFINITY;
                    if (kt - qs >= 8) sv = ((kt - qs) * 16 + r + dlt <= 128) ? sv : -INFINITY;
                    s[kt][qs][r] = sv; mx[qs] = fmaxf(mx[qs], sv); } }
        float inv[2];
#pragma unroll
        for (int qs = 0; qs < 2; ++qs) { mx[qs] = fmaxf(mx[qs], __shfl_xor(mx[qs], 16)); mx[qs] = fmaxf(mx[qs], __shfl_xor(mx[qs], 32)); }
        float sum[2] = {0.f, 0.f};
#pragma unroll
        for (int kt = 0; kt < 10; ++kt)
#pragma unroll
            for (int qs = 0; qs < 2; ++qs)
#pragma unroll
                for (int r = 0; r < 4; ++r) { const float pv = __builtin_amdgcn_exp2f(s[kt][qs][r] - mx[qs]); s[kt][qs][r] = pv; sum[qs] += pv; }
#pragma unroll
        for (int qs = 0; qs < 2; ++qs) { sum[qs] += __shfl_xor(sum[qs], 16); sum[qs] += __shfl_xor(sum[qs], 32); inv[qs] = __builtin_amdgcn_rcpf(sum[qs] + __builtin_amdgcn_exp2f(sink - mx[qs])); }
        f32x4 o[4][2];
#pragma unroll
        for (int dt = 0; dt < 4; ++dt) { o[dt][0] = (f32x4){0.f, 0.f, 0.f, 0.f}; o[dt][1] = (f32x4){0.f, 0.f, 0.f, 0.f}; }
#pragma unroll
        for (int kp = 0; kp < 5; ++kp) {
            bf16x8 pf[2];
#pragma unroll
            for (int qs = 0; qs < 2; ++qs) { u32x4 w; w.x = cvt_pk_bf16(s[2 * kp][qs][0], s[2 * kp][qs][1]); w.y = cvt_pk_bf16(s[2 * kp][qs][2], s[2 * kp][qs][3]);
                w.z = cvt_pk_bf16(s[2 * kp + 1][qs][0], s[2 * kp + 1][qs][1]); w.w = cvt_pk_bf16(s[2 * kp + 1][qs][2], s[2 * kp + 1][qs][3]); pf[qs] = __builtin_bit_cast(bf16x8, w); }
            u32x2 t0r[4], t1r[4];
            { const unsigned a = vtr_base + (unsigned)((i0 + kp * 32) * 144);
              asm volatile("ds_read_b64_tr_b16 %0, %8\n\tds_read_b64_tr_b16 %1, %8 offset:2304\n\tds_read_b64_tr_b16 %2, %8 offset:32\n\tds_read_b64_tr_b16 %3, %8 offset:2336\n\t"
                           "ds_read_b64_tr_b16 %4, %8 offset:64\n\tds_read_b64_tr_b16 %5, %8 offset:2368\n\tds_read_b64_tr_b16 %6, %8 offset:96\n\tds_read_b64_tr_b16 %7, %8 offset:2400\n\ts_waitcnt lgkmcnt(0)"
                           : "=&v"(t0r[0]), "=&v"(t1r[0]), "=&v"(t0r[1]), "=&v"(t1r[1]), "=&v"(t0r[2]), "=&v"(t1r[2]), "=&v"(t0r[3]), "=&v"(t1r[3]) : "v"(a) : "memory"); }
#pragma unroll
            for (int dt = 0; dt < 4; ++dt) { u32x4 aw; aw.x = t0r[dt].x; aw.y = t0r[dt].y; aw.z = t1r[dt].x; aw.w = t1r[dt].y; const bf16x8 vf = __builtin_bit_cast(bf16x8, aw);
                o[dt][0] = mfma16(vf, pf[0], o[dt][0]); o[dt][1] = mfma16(vf, pf[1], o[dt][1]); } }
#pragma unroll
        for (int qs = 0; qs < 2; ++qs)
#pragma unroll
            for (int dt = 0; dt < 4; ++dt) { bf16_t* zp = Z + (size_t)(t0 + i0 + qs * 16 + fr) * 1024 + hq * 64 + dt * 16 + fq * 4;
                const u32x2 z2 = zz[qc][qs][dt]; u32x2 w;
                w.x = cvt_pk_bf16(o[dt][qs][0] * inv[qs] * bf_lo(z2.x), o[dt][qs][1] * inv[qs] * bf_hi(z2.x));
                w.y = cvt_pk_bf16(o[dt][qs][2] * inv[qs] * bf_lo(z2.y), o[dt][qs][3] * inv[qs] * bf_hi(z2.y));
                *(u32x2*)zp = w; }
    }
    __syncthreads();
}

__device__ __forceinline__ void gates_from(float f, int lane, float& bcum) {
    float lf = fminf(f, 0.f) - log1pf(expf(-fabsf(f)));
#pragma unroll
    for (int o = 1; o < 64; o <<= 1) { const float t = __shfl_up(lf, o); if (lane >= o) lf += t; }
    bcum = lf;
}
__device__ __forceinline__ void conv_load(const bf16_t* U, int t, int pos, int bcol, u32x4 (&r)[4]) {
#pragma unroll
    for (int j = 0; j < 4; ++j) { r[j] = (u32x4){0u, 0u, 0u, 0u}; if (pos - 3 + j >= 0) r[j] = *(const u32x4*)(U + (size_t)(t - 3 + j) * 512 + bcol); }
}
__device__ __forceinline__ void conv_compute(const Params& p, const u32x4 (&r)[4], int cch, float (&o)[8]) {
    const f32x4* cb = (const f32x4*)(p.conv_b + cch); const f32x4 b0 = cb[0], b1 = cb[1];
    o[0] = b0.x; o[1] = b0.y; o[2] = b0.z; o[3] = b0.w; o[4] = b1.x; o[5] = b1.y; o[6] = b1.z; o[7] = b1.w;
#pragma unroll
    for (int j = 0; j < 4; ++j) { const u32x4 w = r[j];
        const f32x4* cw = (const f32x4*)(p.conv_w + j * 1024 + cch); const f32x4 w0 = cw[0], w1 = cw[1];
        o[0] += w0.x * bf_lo(w.x); o[1] += w0.y * bf_hi(w.x); o[2] += w0.z * bf_lo(w.y); o[3] += w0.w * bf_hi(w.y);
        o[4] += w1.x * bf_lo(w.z); o[5] += w1.y * bf_hi(w.z); o[6] += w1.z * bf_lo(w.w); o[7] += w1.w * bf_hi(w.w); }
}
__device__ __forceinline__ void vn_load(const Params& p, int ts, int hh, int hl, u32x4 (&vraw)[4]) {
    const bf16_t* MV = (const bf16_t*)(p.ws + OFF_MV);
#pragma unroll
    for (int i = 0; i < 4; ++i) { const int task = hl + 256 * i, vg = task & 15, l = task >> 4; vraw[i] = *(const u32x4*)(MV + (size_t)(ts + l) * 1024 + hh * 128 + vg * 8); }
}
__device__ __forceinline__ void vn_store(LAS bf16_t* Vn, int hl, const u32x4 (&vraw)[4]) {
#pragma unroll
    for (int i = 0; i < 4; ++i) { const int task = hl + 256 * i, vg = task & 15, l = task >> 4; *(LAS u32x4*)(Vn + l * 152 + vg * 8) = vraw[i]; }
    if (hl < 128) { const int l = hl >> 1, h2 = hl & 1; *(LAS u32x4*)(Vn + l * 152 + 128 + h2 * 8) = (u32x4){h2 ? 0u : 0x3F80u, 0u, 0u, 0u}; }
}

__device__ __forceinline__ void mlstm_pass1(const Params& p, LAS unsigned char* lds, int itp) {
    const int tid = threadIdx.x, lane = tid & 63, wave = __builtin_amdgcn_readfirstlane(tid >> 6), fr = lane & 15, fq = lane >> 4;
    const int sub = wave >> 2, hw = wave & 3, hl = tid & 255;
    const int item = 2 * itp + sub, b = item >> 9, hh = (item >> 6) & 7, c = item & 63, ts = b * 4096 + c * 64;
    LAS unsigned char* base = lds + sub * HSZ;
    LAS float* wts = (LAS float*)base;
    LAS bf16_t* Kw = (LAS bf16_t*)(base + 2048);
    LAS bf16_t* Vn = Kw + 64 * 72;
    const float* IF = (const float*)(p.ws + OFF_IF);
    const bf16_t* MK = (const bf16_t*)(p.ws + OFF_MK);
    float gf = 0.f, gi = 0.f;
    if (hw == 0) { gf = IF[(size_t)(ts + lane) * 16 + 8 + hh]; gi = IF[(size_t)(ts + lane) * 16 + hh]; }
    u32x4 kraw[2][4], vraw[4];
#pragma unroll
    for (int i = 0; i < 2; ++i) { const int task = hl + 256 * i, kg = task & 7, l = task >> 3; conv_load(MK, ts + l, c * 64 + l, hh * 64 + kg * 8, kraw[i]); }
    vn_load(p, ts, hh, hl, vraw);
    if (hw == 0) { float bc; gates_from(gf, lane, bc);
        const float gs = __shfl(bc, 63), a = gs - bc + gi, ml = wave_max(a);
        wts[lane] = expf(a - ml);
        if (lane == 0) { ((float*)(p.ws + OFF_MLOC))[item] = ml; ((float*)(p.ws + OFF_GSUM))[item] = gs; }
        const float u = gi - bc; float pm = u;
#pragma unroll
        for (int o = 1; o < 64; o <<= 1) { const float t = __shfl_up(pm, o); if (lane >= o) pm = fmaxf(pm, t); }
        float* gpre = (float*)(p.ws + OFF_GPRE) + (size_t)item * 192;
        gpre[lane] = bc; gpre[64 + lane] = u * 1.44269504f; gpre[128 + lane] = pm; }
    __syncthreads();
#pragma unroll
    for (int i = 0; i < 2; ++i) { const int task = hl + 256 * i, kg = task & 7, l = task >> 3; float kc[8]; conv_compute(p, kraw[i], 512 + hh * 64 + kg * 8, kc);
        const float w = wts[l]; u32x4 wk;
        wk.x = cvt_pk_bf16(silu(kc[0]) * w, silu(kc[1]) * w); wk.y = cvt_pk_bf16(silu(kc[2]) * w, silu(kc[3]) * w);
        wk.z = cvt_pk_bf16(silu(kc[4]) * w, silu(kc[5]) * w); wk.w = cvt_pk_bf16(silu(kc[6]) * w, silu(kc[7]) * w);
        *(LAS u32x4*)(Kw + l * 72 + kg * 8) = wk; }
    vn_store(Vn, hl, vraw);
    __syncthreads();
    f32x4 acc[9];
#pragma unroll
    for (int vt = 0; vt < 9; ++vt) acc[vt] = (f32x4){0.f, 0.f, 0.f, 0.f};
    const unsigned vtr1 = (unsigned)(size_t)Vn + (unsigned)((8 * fq + ((lane & 15) >> 2)) * 304 + (lane & 3) * 8);
    const unsigned ktr1 = (unsigned)(size_t)Kw + (unsigned)((8 * fq + ((lane & 15) >> 2)) * 144 + (lane & 3) * 8 + hw * 32);
#pragma unroll
    for (int ks = 0; ks < 2; ++ks) { u32x2 kt0, kt1;
        { const unsigned a = ktr1 + (unsigned)(ks * 4608);
          asm volatile("ds_read_b64_tr_b16 %0, %2\n\tds_read_b64_tr_b16 %1, %2 offset:576\n\ts_waitcnt lgkmcnt(0)" : "=&v"(kt0), "=&v"(kt1) : "v"(a) : "memory"); }
        u32x4 bw; bw.x = kt0.x; bw.y = kt0.y; bw.z = kt1.x; bw.w = kt1.y; const bf16x8 bf = __builtin_bit_cast(bf16x8, bw);
        u32x2 tr[9][2];
        { const unsigned a = vtr1 + (unsigned)(ks * 9728);
          asm volatile("ds_read_b64_tr_b16 %0, %18\n\tds_read_b64_tr_b16 %1, %18 offset:1216\n\tds_read_b64_tr_b16 %2, %18 offset:32\n\tds_read_b64_tr_b16 %3, %18 offset:1248\n\tds_read_b64_tr_b16 %4, %18 offset:64\n\tds_read_b64_tr_b16 %5, %18 offset:1280\n\tds_read_b64_tr_b16 %6, %18 offset:96\n\tds_read_b64_tr_b16 %7, %18 offset:1312\n\tds_read_b64_tr_b16 %8, %18 offset:128\n\tds_read_b64_tr_b16 %9, %18 offset:1344\n\tds_read_b64_tr_b16 %10, %18 offset:160\n\tds_read_b64_tr_b16 %11, %18 offset:1376\n\tds_read_b64_tr_b16 %12, %18 offset:192\n\tds_read_b64_tr_b16 %13, %18 offset:1408\n\tds_read_b64_tr_b16 %14, %18 offset:224\n\tds_read_b64_tr_b16 %15, %18 offset:1440\n\tds_read_b64_tr_b16 %16, %18 offset:256\n\tds_read_b64_tr_b16 %17, %18 offset:1472\n\ts_waitcnt lgkmcnt(0)" : "=&v"(tr[0][0]), "=&v"(tr[0][1]), "=&v"(tr[1][0]), "=&v"(tr[1][1]), "=&v"(tr[2][0]), "=&v"(tr[2][1]), "=&v"(tr[3][0]), "=&v"(tr[3][1]), "=&v"(tr[4][0]), "=&v"(tr[4][1]), "=&v"(tr[5][0]), "=&v"(tr[5][1]), "=&v"(tr[6][0]), "=&v"(tr[6][1]), "=&v"(tr[7][0]), "=&v"(tr[7][1]), "=&v"(tr[8][0]), "=&v"(tr[8][1]) : "v"(a) : "memory"); }
#pragma unroll
        for (int vt = 0; vt < 9; ++vt) { u32x4 aw; aw.x = tr[vt][0].x; aw.y = tr[vt][0].y; aw.z = tr[vt][1].x; aw.w = tr[vt][1].y; acc[vt] = mfma16(__builtin_bit_cast(bf16x8, aw), bf, acc[vt]); } }
    bf16_t* cst = (bf16_t*)((unsigned char*)p.out + OUT_CST) + (size_t)item * 9216;
#pragma unroll
    for (int vt = 0; vt < 9; ++vt)
#pragma unroll
        for (int r = 0; r < 4; ++r) cst[(vt * 16 + fq * 4 + r) * 64 + hw * 16 + fr] = f2bf(acc[vt][r]);
    __syncthreads();
}


__device__ __forceinline__ void mlstm_scan(const Params& p, int G) {
    const float* mloc = (const float*)(p.ws + OFF_MLOC); const float* gsum = (const float*)(p.ws + OFF_GSUM); float* mprev = (float*)(p.ws + OFF_MPREV);
    bf16_t* cst = (bf16_t*)((unsigned char*)p.out + OUT_CST);
    for (int task = blockIdx.x * 512 + threadIdx.x; task < 32 * 2304; task += G * 512) {
        const int bh = task / 2304, e = task % 2304;
        float s0 = 0.f, s1 = 0.f, s2 = 0.f, s3 = 0.f, m = -1e30f;
        u32x2* ptr = (u32x2*)(cst + (size_t)bh * 64 * 9216 + e * 4);
        for (int c0 = 0; c0 < 64; c0 += 16) { u32x2 clv[16]; float glv[16], mlv[16];
#pragma unroll
            for (int i = 0; i < 16; ++i) { clv[i] = ptr[(size_t)i * (9216 / 4)]; glv[i] = gsum[bh * 64 + c0 + i]; mlv[i] = mloc[bh * 64 + c0 + i]; }
#pragma unroll
            for (int i = 0; i < 16; ++i) { const float gl = glv[i], ml = mlv[i]; const u32x2 cl = clv[i];
                u32x2 w; w.x = cvt_pk_bf16(s0, s1); w.y = cvt_pk_bf16(s2, s3); ptr[(size_t)i * (9216 / 4)] = w;
                if (e == 0) mprev[bh * 64 + c0 + i] = m;
                const float mn = fmaxf(gl + m, ml), sp = __expf(gl + m - mn), sl = __expf(ml - mn);
                s0 = sp * s0 + sl * bf_lo(cl.x); s1 = sp * s1 + sl * bf_hi(cl.x); s2 = sp * s2 + sl * bf_lo(cl.y); s3 = sp * s3 + sl * bf_hi(cl.y);
                m = mn; }
            ptr += 16 * (9216 / 4); }
    }
}

__device__ __forceinline__ void mlstm_pass3(const Params& p, LAS unsigned char* lds, int itp) {
    const int tid = threadIdx.x, lane = tid & 63, wave = __builtin_amdgcn_readfirstlane(tid >> 6), fr = lane & 15, fq = lane >> 4;
    const int sub = wave >> 2, hw = wave & 3, hl = tid & 255;
    const int item = 2 * itp + sub, b = item >> 9, hh = (item >> 6) & 7, c = item & 63, ts = b * 4096 + c * 64;
    LAS unsigned char* base = lds + sub * HSZ;
    LAS float* fb = (LAS float*)base; LAS float* fu = fb + 64; LAS float* fM = fb + 128; LAS float* fI = fb + 192;
    LAS bf16_t* Ks = (LAS bf16_t*)(base + 2048);
    LAS bf16_t* Vn = Ks + 64 * 72;
    LAS bf16_t* Qs = Vn + 64 * 152;
    const float* IF = (const float*)(p.ws + OFF_IF);
    const bf16_t* MQ = (const bf16_t*)(p.ws + OFF_MQ); const bf16_t* MK = (const bf16_t*)(p.ws + OFF_MK);
    bf16_t* OG = (bf16_t*)(p.ws + OFF_OG);
    const bf16_t* cst = (const bf16_t*)((unsigned char*)p.out + OUT_CST) + (size_t)item * 9216;
    float gf = 0.f, gi = 0.f, mp = 0.f;
    float gp = 0.f;
    if (hw == 0) { const float* gpre = (const float*)(p.ws + OFF_GPRE) + (size_t)item * 192; gf = gpre[lane]; gi = gpre[64 + lane]; gp = gpre[128 + lane]; mp = ((const float*)(p.ws + OFF_MPREV))[item]; }
    u32x4 qraw[2][4], kraw[2][4], vraw[4];
#pragma unroll
    for (int i = 0; i < 2; ++i) { const int task = hl + 256 * i, kg = task & 7, l = task >> 3;
        conv_load(MQ, ts + l, c * 64 + l, hh * 64 + kg * 8, qraw[i]); conv_load(MK, ts + l, c * 64 + l, hh * 64 + kg * 8, kraw[i]); }
    vn_load(p, ts, hh, hl, vraw);
    if (hw == 0) { const float M = fmaxf(mp, gp);
        fb[lane] = gf; fu[lane] = gi; fM[lane] = M; fI[lane] = expf(mp - M); }
#pragma unroll
    for (int i = 0; i < 2; ++i) { const int task = hl + 256 * i, kg = task & 7, l = task >> 3; float qc[8], kc[8];
        conv_compute(p, qraw[i], hh * 64 + kg * 8, qc); conv_compute(p, kraw[i], 512 + hh * 64 + kg * 8, kc);
        u32x4 wq, wk;
        wq.x = cvt_pk_bf16(0.125f * silu(qc[0]), 0.125f * silu(qc[1])); wq.y = cvt_pk_bf16(0.125f * silu(qc[2]), 0.125f * silu(qc[3]));
        wq.z = cvt_pk_bf16(0.125f * silu(qc[4]), 0.125f * silu(qc[5])); wq.w = cvt_pk_bf16(0.125f * silu(qc[6]), 0.125f * silu(qc[7]));
        wk.x = cvt_pk_bf16(silu(kc[0]), silu(kc[1])); wk.y = cvt_pk_bf16(silu(kc[2]), silu(kc[3]));
        wk.z = cvt_pk_bf16(silu(kc[4]), silu(kc[5])); wk.w = cvt_pk_bf16(silu(kc[6]), silu(kc[7]));
        *(LAS u32x4*)(Qs + l * 72 + kg * 8) = wq; *(LAS u32x4*)(Ks + l * 72 + kg * 8) = wk; }
    vn_store(Vn, hl, vraw);
    __syncthreads();
    const int l = hw * 16 + fr;
    const unsigned vtr3 = (unsigned)(size_t)Vn + (unsigned)((4 * fq + ((lane & 15) >> 2)) * 304 + (lane & 3) * 8);
    bf16x8 qf[2];
#pragma unroll
    for (int ks = 0; ks < 2; ++ks) qf[ks] = *(const LAS bf16x8*)(Qs + l * 72 + ks * 32 + fq * 8);
    f32x4 sT[4];
#pragma unroll
    for (int st = 0; st < 4; ++st) { sT[st] = (f32x4){0.f, 0.f, 0.f, 0.f};
#pragma unroll
        for (int ks = 0; ks < 2; ++ks) { const bf16x8 kf = *(const LAS bf16x8*)(Ks + (st * 16 + fr) * 72 + ks * 32 + fq * 8); sT[st] = mfma16(kf, qf[ks], sT[st]); } }
    const float Ml = fM[l], Ml2 = Ml * 1.44269504f;
#pragma unroll
    for (int st = 0; st < 4; ++st) { const f32x4 uv = *(const LAS f32x4*)(fu + st * 16 + fq * 4);
#pragma unroll
        for (int r = 0; r < 4; ++r) { const int s = st * 16 + fq * 4 + r; sT[st][r] = (s <= l) ? sT[st][r] * __builtin_amdgcn_exp2f(uv[r] - Ml2) : 0.f; } }
    f32x4 ai[9], ae[9];
#pragma unroll
    for (int vt = 0; vt < 9; ++vt) { ai[vt] = (f32x4){0.f, 0.f, 0.f, 0.f}; ae[vt] = (f32x4){0.f, 0.f, 0.f, 0.f}; }
#pragma unroll
    for (int kk = 0; kk < 2; ++kk) {
        u32x4 w; w.x = cvt_pk_bf16(sT[2 * kk][0], sT[2 * kk][1]); w.y = cvt_pk_bf16(sT[2 * kk][2], sT[2 * kk][3]);
        w.z = cvt_pk_bf16(sT[2 * kk + 1][0], sT[2 * kk + 1][1]); w.w = cvt_pk_bf16(sT[2 * kk + 1][2], sT[2 * kk + 1][3]);
        const bf16x8 pf = __builtin_bit_cast(bf16x8, w);
        u32x2 tr[9][2];
        { const unsigned a = vtr3 + (unsigned)(kk * 9728);
          asm volatile("ds_read_b64_tr_b16 %0, %18\n\tds_read_b64_tr_b16 %1, %18 offset:4864\n\tds_read_b64_tr_b16 %2, %18 offset:32\n\tds_read_b64_tr_b16 %3, %18 offset:4896\n\tds_read_b64_tr_b16 %4, %18 offset:64\n\tds_read_b64_tr_b16 %5, %18 offset:4928\n\tds_read_b64_tr_b16 %6, %18 offset:96\n\tds_read_b64_tr_b16 %7, %18 offset:4960\n\tds_read_b64_tr_b16 %8, %18 offset:128\n\tds_read_b64_tr_b16 %9, %18 offset:4992\n\tds_read_b64_tr_b16 %10, %18 offset:160\n\tds_read_b64_tr_b16 %11, %18 offset:5024\n\tds_read_b64_tr_b16 %12, %18 offset:192\n\tds_read_b64_tr_b16 %13, %18 offset:5056\n\tds_read_b64_tr_b16 %14, %18 offset:224\n\tds_read_b64_tr_b16 %15, %18 offset:5088\n\tds_read_b64_tr_b16 %16, %18 offset:256\n\tds_read_b64_tr_b16 %17, %18 offset:5120\n\ts_waitcnt lgkmcnt(0)" : "=&v"(tr[0][0]), "=&v"(tr[0][1]), "=&v"(tr[1][0]), "=&v"(tr[1][1]), "=&v"(tr[2][0]), "=&v"(tr[2][1]), "=&v"(tr[3][0]), "=&v"(tr[3][1]), "=&v"(tr[4][0]), "=&v"(tr[4][1]), "=&v"(tr[5][0]), "=&v"(tr[5][1]), "=&v"(tr[6][0]), "=&v"(tr[6][1]), "=&v"(tr[7][0]), "=&v"(tr[7][1]), "=&v"(tr[8][0]), "=&v"(tr[8][1]) : "v"(a) : "memory"); }
#pragma unroll
        for (int vt = 0; vt < 9; ++vt) { u32x4 aw; aw.x = tr[vt][0].x; aw.y = tr[vt][0].y; aw.z = tr[vt][1].x; aw.w = tr[vt][1].y;
            ai[vt] = mfma16(__builtin_bit_cast(bf16x8, aw), pf, ai[vt]);
            const bf16x8 cf = *(const bf16x8*)(cst + (vt * 16 + fr) * 64 + kk * 32 + fq * 8);
            ae[vt] = mfma16(cf, qf[kk], ae[vt]); } }
    const float inter = fI[l];
#pragma unroll
    for (int vt = 0; vt < 9; ++vt) ai[vt] = ai[vt] + inter * ae[vt];
    const float den = __shfl(ai[8][0], fr);
    const float rD = 1.f / fmaxf(fabsf(den), expf(-(fb[l] + Ml)));
    float ss = 0.f;
#pragma unroll
    for (int vt = 0; vt < 8; ++vt) { ai[vt] = ai[vt] * rD; ss += (ai[vt][0] * ai[vt][0] + ai[vt][1] * ai[vt][1]) + (ai[vt][2] * ai[vt][2] + ai[vt][3] * ai[vt][3]); }
    ss += __shfl_xor(ss, 16); ss += __shfl_xor(ss, 32);
    const float rs = rsqrtf(ss * (1.f / 128.f) + 1e-6f);
#pragma unroll
    for (int vt = 0; vt < 8; ++vt) { const int v0 = vt * 16 + fq * 4; bf16_t* op = OG + (size_t)(ts + l) * 1024 + hh * 128 + v0;
        const u32x2 og = *(const u32x2*)op; const f32x4 nw = *(const f32x4*)(p.mnorm_w + hh * 128 + v0);
        u32x2 w; w.x = cvt_pk_bf16(bf_lo(og.x) * ai[vt][0] * rs * nw.x, bf_hi(og.x) * ai[vt][1] * rs * nw.y);
        w.y = cvt_pk_bf16(bf_lo(og.y) * ai[vt][2] * rs * nw.z, bf_hi(og.y) * ai[vt][3] * rs * nw.w);
        *(u32x2*)op = w; }
    __syncthreads();
}


struct PairOrder {
    StaticOrder so;
    __device__ bool next(int i, Unit& u) const { if (!so.next(i >> 1, u)) return false; if (i & 1) { u.pm += 64; u.pn += 4; } return true; }
    __device__ __forceinline__ void a_ready(const Unit&) const {}
    __device__ __forceinline__ void done(const Unit&) const {}
};
struct EpiMerge {
    static constexpr bool PERM = true, AFTER_DRAIN = false;
    const bf16_t *GA, *GM; bf16_t* Mg;
    __device__ __forceinline__ bool keep(const Unit& u) const { return u.pn < 4; }
    __device__ __forceinline__ void operator()(f32x4 (&acc)[2][2][4][2], const Unit& u, int ui, int wr, int wc, int fr, int fq) const {
        const bool first = u.pn < 4; const int pm = first ? u.pm : u.pm - 64, pn = first ? u.pn : u.pn - 4;
        const int row0 = pm * BM + wr * 64 + fr, col0 = pn * BM + wc * 32 + 8 * fq;
#pragma unroll
        for (int ai = 0; ai < 2; ++ai)
#pragma unroll
            for (int m = 0; m < 4; ++m)
#pragma unroll
                for (int bj = 0; bj < 2; ++bj) { const size_t idx = (size_t)(row0 + ai * HALF + m * 16) * 1024 + col0 + bj * HALF;
                    const u32x4 gm = *(const u32x4*)((first ? GA : GM) + idx);
                    float gmf[8] = {bf_lo(gm.x), bf_hi(gm.x), bf_lo(gm.y), bf_hi(gm.y), bf_lo(gm.z), bf_hi(gm.z), bf_lo(gm.w), bf_hi(gm.w)};
                    if (first) {
#pragma unroll
                        for (int i = 0; i < 4; ++i) { acc[ai][bj][m][0][i] *= gmf[i]; acc[ai][bj][m][1][i] *= gmf[4 + i]; } }
                    else { u32x4 w;
                        w.x = cvt_pk_bf16(acc[ai][bj][m][0][0] * gmf[0], acc[ai][bj][m][0][1] * gmf[1]); w.y = cvt_pk_bf16(acc[ai][bj][m][0][2] * gmf[2], acc[ai][bj][m][0][3] * gmf[3]);
                        w.z = cvt_pk_bf16(acc[ai][bj][m][1][0] * gmf[4], acc[ai][bj][m][1][1] * gmf[5]); w.w = cvt_pk_bf16(acc[ai][bj][m][1][2] * gmf[6], acc[ai][bj][m][1][3] * gmf[7]);
                        *(u32x4*)(Mg + idx) = w; } }
    }
};
struct EpiOut {
    static constexpr bool PERM = false, AFTER_DRAIN = false;
    const float* x; float* out;
    __device__ __forceinline__ bool keep(const Unit&) const { return false; }
    __device__ __forceinline__ void operator()(const f32x4 (&acc)[2][2][4][2], const Unit& u, int ui, int wr, int wc, int fr, int fq) const {
        const int row0 = u.pm * BM + wr * 64 + fr, col0 = u.pn * BM + wc * 32 + 4 * fq;
#pragma unroll
        for (int ai = 0; ai < 2; ++ai)
#pragma unroll
            for (int m = 0; m < 4; ++m) { const size_t ro = (size_t)(row0 + ai * HALF + m * 16) * 1024 + col0;
#pragma unroll
                for (int bj = 0; bj < 2; ++bj)
#pragma unroll
                    for (int n = 0; n < 2; ++n) { const f32x4 xv = *(const f32x4*)(x + ro + bj * HALF + n * 16); *(f32x4*)(out + ro + bj * HALF + n * 16) = acc[ai][bj][m][n] + xv; } }
    }
};

struct EpiOutNorm {
    static constexpr bool PERM = false, AFTER_DRAIN = true;
    const float* x; float* out; const float* fw; float* rowss; unsigned* pcnt;
    __device__ __forceinline__ bool keep(const Unit&) const { return false; }
    __device__ __forceinline__ void fused(f32x4 (&acc)[2][2][4][2], const Unit& u, int wr, int wc, int fr, int fq, PG8_LAS unsigned char*, int wid, int lane) const {
        const int row0 = u.pm * BM + wr * 64 + fr, col0 = u.pn * BM + wc * 32 + 4 * fq;
        float dummy = 0.f;
#pragma unroll
        for (int ai = 0; ai < 2; ++ai) { f32x4 xv[4][2][2];
#pragma unroll
            for (int m = 0; m < 4; ++m) { const size_t ro = (size_t)(row0 + ai * HALF + m * 16) * 1024 + col0;
#pragma unroll
                for (int bj = 0; bj < 2; ++bj)
#pragma unroll
                    for (int n = 0; n < 2; ++n) xv[m][bj][n] = *(const f32x4*)(x + ro + bj * HALF + n * 16); }
#pragma unroll
            for (int m = 0; m < 4; ++m) { float ss = 0.f;
#pragma unroll
                for (int bj = 0; bj < 2; ++bj)
#pragma unroll
                    for (int n = 0; n < 2; ++n) { const f32x4 v = acc[ai][bj][m][n] + xv[m][bj][n]; acc[ai][bj][m][n] = v; ss += (v.x * v.x + v.y * v.y) + (v.z * v.z + v.w * v.w); }
                ss += __shfl_xor(ss, 16); ss += __shfl_xor(ss, 32);
                if (fq == 0) dummy += __hip_atomic_fetch_add(rowss + row0 + ai * HALF + m * 16, ss, __ATOMIC_RELAXED, __HIP_MEMORY_SCOPE_AGENT); }
            __builtin_amdgcn_sched_barrier(0); }
        asm volatile("s_waitcnt vmcnt(0)" :: "v"(dummy) : "memory");
        __syncthreads();
        if (wid == 0 && lane == 0) { unsigned* cnt = pcnt + 64 * u.pm;
            (void)__hip_atomic_fetch_add(cnt, 1u, __ATOMIC_RELAXED, __HIP_MEMORY_SCOPE_AGENT);
            unsigned sp = 0;
            while (__hip_atomic_load(cnt, __ATOMIC_RELAXED, __HIP_MEMORY_SCOPE_AGENT) < 4u) { __builtin_amdgcn_s_sleep(8); if (++sp > (1u << 17)) break; } }
        __syncthreads();
        f32x4 wv[2][2];
#pragma unroll
        for (int bj = 0; bj < 2; ++bj)
#pragma unroll
            for (int n = 0; n < 2; ++n) wv[bj][n] = *(const f32x4*)(fw + col0 + bj * HALF + n * 16);
        float tot[2][4];
#pragma unroll
        for (int ai = 0; ai < 2; ++ai)
#pragma unroll
            for (int m = 0; m < 4; ++m) { tot[ai][m] = 0.f; if (fq == 0) tot[ai][m] = __hip_atomic_fetch_add(rowss + row0 + ai * HALF + m * 16, 0.0f, __ATOMIC_RELAXED, __HIP_MEMORY_SCOPE_AGENT); }
#pragma unroll
        for (int ai = 0; ai < 2; ++ai)
#pragma unroll
            for (int m = 0; m < 4; ++m) { const int row = row0 + ai * HALF + m * 16;
                const float rstd = rsqrtf(__shfl(tot[ai][m], fr) * (1.f / 1024.f) + 1e-6f);
                const size_t ro = (size_t)row * 1024 + col0;
#pragma unroll
                for (int bj = 0; bj < 2; ++bj)
#pragma unroll
                    for (int n = 0; n < 2; ++n) *(f32x4*)(out + ro + bj * HALF + n * 16) = acc[ai][bj][m][n] * rstd * wv[bj][n]; }
    }
};


#define XB_TMO      128
#define XB_XCNT(j)  (256  + 64 * (j))
#define XB_XSUB(j)  (1280 + 64 * (j))
#define XB_XGEN(j)  (2304 + 64 * (j))
#define XB_TOP      3328
#define XB_TOPGEN   3392
#define XCD_BAR_WORDS 3456
#define XB_SPIN_CAP (1u << 18)

__device__ __forceinline__ unsigned xb_ld(unsigned* p)              { return __hip_atomic_load(p, __ATOMIC_RELAXED, __HIP_MEMORY_SCOPE_AGENT); }
__device__ __forceinline__ unsigned xb_add(unsigned* p, unsigned v) { return __hip_atomic_fetch_add(p, v, __ATOMIC_RELAXED, __HIP_MEMORY_SCOPE_AGENT); }
__device__ __forceinline__ unsigned xb_xcc_id() { return (unsigned)__builtin_amdgcn_s_getreg((3 << 11) | 20) & 0xFu; }
#define XB_SPIN(cond, bar) do { unsigned _sp = 0; while (cond) { __builtin_amdgcn_s_sleep(1); \
    if ((++_sp & 255u) == 0u) { if (xb_ld(&(bar)[XB_TMO])) break; if (_sp > XB_SPIN_CAP) { atomicAdd(&(bar)[XB_TMO], 1u); break; } } } } while (0)

struct XcdBarrier {
    unsigned* bar; unsigned x;
    volatile LAS unsigned* st;
};

__device__ __forceinline__ XcdBarrier xcd_barrier_post(unsigned* bar, volatile LAS unsigned* st) {
    XcdBarrier b; b.bar = bar; b.x = xb_xcc_id(); b.st = st;
    if (threadIdx.x == 0) (void)xb_add(&bar[XB_XCNT(b.x)], 1u);
    return b;
}
__device__ __forceinline__ void xcd_barrier_complete(unsigned* bar, unsigned x, unsigned& nloc, unsigned& nx) {
    const unsigned G = gridDim.x * gridDim.y * gridDim.z;
    unsigned sum, cnt, mine, sp = 0u;
    for (;;) {
        sum = 0u; cnt = 0u; mine = 0u;
#pragma unroll
        for (unsigned j = 0; j < 16; ++j) { const unsigned c = xb_ld(&bar[XB_XCNT(j)]); sum += c; cnt += (c > 0u) ? 1u : 0u; mine = (j == x) ? c : mine; }
        if (sum == G) break;
        __builtin_amdgcn_s_sleep(1);
        if ((++sp & 255u) == 0u) { if (xb_ld(&bar[XB_TMO])) break; if (sp > XB_SPIN_CAP) { atomicAdd(&bar[XB_TMO], 1u); break; } }
    }
    nloc = mine > 0u ? mine : 1u; nx = cnt > 0u ? cnt : 1u;
}

__device__ __forceinline__ void xcd_barrier(const XcdBarrier& b) {
    asm volatile("s_waitcnt vmcnt(0)" ::: "memory");
    __syncthreads();
    if (threadIdx.x == 0) {
        unsigned* bar = b.bar;
        __builtin_amdgcn_s_waitcnt(0);
        unsigned nloc = b.st[0], nx = b.st[1];
        if (nloc == 0u) { xcd_barrier_complete(bar, b.x, nloc, nx); b.st[0] = nloc; b.st[1] = nx; }
        const unsigned old = xb_add(&bar[XB_XSUB(b.x)], 1u);
        const unsigned gen = old / nloc;
        if (old + 1u == (gen + 1u) * nloc) {
            __builtin_amdgcn_fence(__ATOMIC_RELEASE, "agent");
            asm volatile("s_waitcnt vmcnt(0)" ::: "memory");
            const unsigned og = xb_add(&bar[XB_TOP], 1u);
            const unsigned tg = og / nx;
            if (og + 1u == (tg + 1u) * nx) xb_add(&bar[XB_TOPGEN], 1u);
            else XB_SPIN(xb_ld(&bar[XB_TOPGEN]) == tg, bar);
            __builtin_amdgcn_fence(__ATOMIC_ACQUIRE, "agent");
            xb_add(&bar[XB_XGEN(b.x)], 1u);
            asm volatile("s_waitcnt vmcnt(0)" ::: "memory");
        } else {
            XB_SPIN(xb_ld(&bar[XB_XGEN(b.x)]) == gen, bar);
            __builtin_amdgcn_fence(__ATOMIC_ACQUIRE, "agent");
            asm volatile("s_waitcnt vmcnt(0)" ::: "memory");
        }
    }
    __syncthreads();
}

__global__ void __launch_bounds__(512, 2) mega(Params p) {
    extern __shared__ __attribute__((aligned(16))) unsigned char shm[];
    LAS unsigned char* lds = (LAS unsigned char*)shm;
    const int G = gridDim.x;
    volatile LAS unsigned* xbw = (volatile LAS unsigned*)(lds + 131072);
    if (threadIdx.x < 4) xbw[threadIdx.x] = 0u;
    __syncthreads();
    const XcdBarrier xb = xcd_barrier_post((unsigned*)(p.ws + OFF_BAR), xbw);
#ifndef PROBE_MASK
#define PROBE_MASK 0
#endif
    unsigned long long pt0 = PROBE_MASK ? wall_clock64() : 0ull;
#define PHASE(n) if (p.ph_lo <= (n) && (n) < p.ph_hi)
#define SEAM(n) if (PROBE_MASK) { if ((PROBE_MASK >> ((n) - 1)) & 1) { __syncthreads(); const unsigned long long pt1 = wall_clock64(); while (wall_clock64() - pt1 < pt1 - pt0) __builtin_amdgcn_s_sleep(8); } } \
    if (p.ph_lo < (n) && (n) < p.ph_hi) xcd_barrier(xb); if (PROBE_MASK) pt0 = wall_clock64();
    PHASE(0) phase0(p, lds, G);
    SEAM(1)
    PHASE(1) {
        Gemm g; g.A = (const bf16_t*)((unsigned char*)p.out + OUT_H); g.Bt = (const bf16_t*)((unsigned char*)p.out + OUT_WTIN); g.M = T_TOK; g.N = NPT; g.K = 1024;
        StaticOrder S; S.init(T_TOK, NPT, G, blockIdx.x);
        LAS float* biasl = (LAS float*)(lds + 131072 + 16);
        { const float* biasp = (const float*)(p.ws + OFF_BIASP); Unit u;
          for (int i = 0; i < BIAS_UNITS && S.next(i, u); ++i) if (threadIdx.x < 256) biasl[i * 256 + threadIdx.x] = biasp[u.pn * 256 + threadIdx.x];
          __syncthreads(); }
        Epi1 E; E.ws = p.ws; E.biasl = biasl;
        gemm_phase<Epi1, StaticOrder, true, true>(lds, g, S, E);
        if (G == 256 && blockIdx.x >= 192) square_transposes(p, lds, (blockIdx.x - 192) * 8 + (threadIdx.x >> 6), 512);
    }
    SEAM(2)
    PHASE(2) {
        for (int it = blockIdx.x; it < 512; it += G) attn_item(p, lds, it);
        for (int itp = blockIdx.x; itp < 1024; itp += G) mlstm_pass1(p, lds, itp);
    }
    SEAM(3)
    PHASE(3) mlstm_scan(p, G);
    SEAM(4)
    PHASE(4) { for (int itp = blockIdx.x; itp < 1024; itp += G) mlstm_pass3(p, lds, itp); }
    SEAM(5)
    PHASE(5) {
        Gemm g; g.A = (const bf16_t*)(p.ws + OFF_Z); g.Bt = (const bf16_t*)(p.ws + OFF_WAT); g.M = T_TOK; g.N = 1024; g.K = 1024;
        PairOrder S; S.so.init(T_TOK, 1024, G, blockIdx.x);
        EpiMerge E; E.GA = (const bf16_t*)(p.ws + OFF_GA); E.GM = (const bf16_t*)(p.ws + OFF_GM); E.Mg = (bf16_t*)(p.ws + OFF_Q);
        gemm_phase<EpiMerge, PairOrder, true, true>(lds, g, S, E);
    }
    SEAM(6)
    PHASE(6) {
        Gemm g; g.A = (const bf16_t*)(p.ws + OFF_Q); g.Bt = (const bf16_t*)(p.ws + OFF_WOT); g.M = T_TOK; g.N = 1024; g.K = 1024;
        StaticOrder S; S.init(T_TOK, 1024, G, blockIdx.x);
        if (G == 256) { EpiOutNorm E; E.x = p.x; E.out = p.out; E.fw = p.fnorm_w; E.rowss = (float*)(p.ws + OFF_ROWSS); E.pcnt = (unsigned*)(p.ws + OFF_PCNT);
            gemm_phase<EpiOutNorm, StaticOrder, false, true>(lds, g, S, E); }
        else { EpiOut E; E.x = p.x; E.out = p.out; gemm_phase<EpiOut, StaticOrder, true, true>(lds, g, S, E); }
    }
    if (G != 256) {
    SEAM(7)
    PHASE(7) {
        const int lane = threadIdx.x & 63, gw = blockIdx.x * 8 + (threadIdx.x >> 6);
        f32x4 nwv[4];
#pragma unroll
        for (int j = 0; j < 4; ++j) nwv[j] = ((const f32x4*)p.fnorm_w)[64 * j + lane];
        for (int row = gw; row < T_TOK; row += G * 32) {
            f32x4 v[4][4];
#pragma unroll
            for (int i = 0; i < 4; ++i) { const int r = row + i * G * 8;
                if (r < T_TOK) {
#pragma unroll
                    for (int j = 0; j < 4; ++j) v[i][j] = ((const f32x4*)(p.out + (size_t)r * 1024) + lane)[64 * j]; } }
#pragma unroll
            for (int i = 0; i < 4; ++i) { const int r = row + i * G * 8;
                if (r < T_TOK) { float ss = 0.f;
#pragma unroll
                    for (int j = 0; j < 4; ++j) ss += (v[i][j].x * v[i][j].x + v[i][j].y * v[i][j].y) + (v[i][j].z * v[i][j].z + v[i][j].w * v[i][j].w);
                    ss = wave_sum(ss);
                    const float rstd = rsqrtf(ss * (1.f / 1024.f) + 1e-6f);
#pragma unroll
                    for (int j = 0; j < 4; ++j) ((f32x4*)(p.out + (size_t)r * 1024) + lane)[64 * j] = v[i][j] * rstd * nwv[j]; } }
        }
    }
    }
}

extern "C" void kernel_launch(void* const* d_in, const int* in_sizes, int n_in, void* d_out, int out_size, void* d_ws, size_t ws_size, hipStream_t stream) {
    static int grid = 0;
    if (grid == 0) {
        if (n_in != 12 || out_size != T_TOK * 1024 || ws_size < OFF_GPRE + 2 * MiB) { fprintf(stderr, "kernel_launch: unexpected shapes (n_in %d out %d ws %zu)\n", n_in, out_size, ws_size); grid = -1; return; }
        int dev = 0, cus = 0, per_cu = 0;
        (void)hipGetDevice(&dev); (void)hipDeviceGetAttribute(&cus, hipDeviceAttributeMultiprocessorCount, dev);
        if (hipFuncSetAttribute((const void*)mega, hipFuncAttributeMaxDynamicSharedMemorySize, LDS_BYTES) != hipSuccess) { fprintf(stderr, "kernel_launch: hipFuncSetAttribute failed\n"); grid = -1; return; }
        if (hipOccupancyMaxActiveBlocksPerMultiprocessor(&per_cu, (const void*)mega, 512, LDS_BYTES) != hipSuccess || per_cu < 1) { fprintf(stderr, "kernel_launch: occupancy query failed (%d)\n", per_cu); grid = -1; return; }
        grid = cus * per_cu;
    }
    if (grid < 0) return;
    if (hipMemsetAsync((char*)d_ws + OFF_BAR, 0, (size_t)(OFF_ROWSS + 65536 - OFF_BAR), stream) != hipSuccess) { fprintf(stderr, "kernel_launch: memset failed\n"); return; }
    Params p{};
    p.x = (const float*)d_in[0]; p.norm_w = (const float*)d_in[1]; p.w_in = (const float*)d_in[2]; p.b_in = (const float*)d_in[3]; p.sinks = (const float*)d_in[4];
    p.conv_w = (const float*)d_in[5]; p.conv_b = (const float*)d_in[6]; p.mnorm_w = (const float*)d_in[7]; p.w_ba = (const float*)d_in[8]; p.w_bm = (const float*)d_in[9];
    p.w_out = (const float*)d_in[10]; p.fnorm_w = (const float*)d_in[11];
    p.out = (float*)d_out; p.ws = (unsigned char*)d_ws; p.ph_lo = 0; p.ph_hi = 8;
    void* args[] = {&p};
    hipError_t e = hipLaunchCooperativeKernel((const void*)mega, dim3(grid), dim3(512), args, LDS_BYTES, stream);
    if (e != hipSuccess) fprintf(stderr, "kernel_launch: cooperative launch failed: %s (grid %d)\n", hipGetErrorString(e), grid);
}
```
